# Optimizing an MI355X kernel written in HIP

```python
import jax, jax.numpy as jnp
from jax import lax
import numpy as np

D_MODEL = 1024
BATCH = 8
SEQ = 4096
DEPTH = 2

PLE_DIM = 256
MIX_W = 512
N_BRANCH = 4
POOL_WINDOWS = (2, 4, 8, 16)
POOL_GROUP = MIX_W // len(POOL_WINDOWS)
RWKV_HEAD = 64
RWKV_HEADS = MIX_W // RWKV_HEAD
RWKV_DECAY_RANK = 64
RWKV_A_RANK = 64
RWKV_G_RANK = 128
RWKV_LN_EPS = 64e-5
RWKV_IN = 3 * MIX_W + RWKV_DECAY_RANK + RWKV_A_RANK + RWKV_G_RANK
RWKV_SPLITS = [MIX_W, 2 * MIX_W, 3 * MIX_W, 3 * MIX_W + RWKV_DECAY_RANK,
               3 * MIX_W + RWKV_DECAY_RANK + RWKV_A_RANK]
SG_CHUNK = 128
SG_GROUPS = 4
SG_GROUP_W = MIX_W // SG_GROUPS
SG_LN_EPS = 1e-5
HGRN_EXPAND = 128
HGRN_HEADS = MIX_W // HGRN_EXPAND
HGRN_CHUNK = 64
GATE_FLOOR = 1e-30
D_FF = 2816
CONV_W = 3
NORM_EPS = 1e-6
COL_A = MIX_W
COL_B = RWKV_IN
COL_C = 2 * MIX_W
COL_D = 3 * MIX_W
COL_G = N_BRANCH * D_MODEL
D_IN = COL_A + COL_B + COL_C + COL_D + COL_G
IN_SPLITS = [COL_A, COL_A + COL_B, COL_A + COL_B + COL_C, COL_A + COL_B + COL_C + COL_D]

kernel_name = "hybrid_pool_rwkv7_gmlp_hgrn2_block"


def rmsnorm(x, g, eps=NORM_EPS):
    x32 = x.astype(jnp.float32)
    y = x32 * lax.rsqrt(jnp.mean(x32 * x32, axis=-1, keepdims=True) + eps)
    return (y * g.astype(jnp.float32)).astype(x.dtype)


def shift_right(x, n=1):
    return jnp.pad(x, ((0, 0), (n, 0), (0, 0)))[:, :x.shape[1]]


def pool_mixer(a, w_group, scale):
    B, S, _ = a.shape
    a32 = a.astype(jnp.float32)
    csum = jnp.cumsum(a32, axis=1)
    count = jnp.arange(1, S + 1, dtype=jnp.float32)[None, :, None]
    diffs = []
    for gi, win in enumerate(POOL_WINDOWS):
        c = csum[..., gi * POOL_GROUP:(gi + 1) * POOL_GROUP]
        mean = (c - shift_right(c, win)) / jnp.minimum(count, win)
        diffs.append(mean - a32[..., gi * POOL_GROUP:(gi + 1) * POOL_GROUP])
    d = jnp.stack(diffs, axis=2).astype(a.dtype)
    y = jnp.einsum('bsgc,gcd->bsgd', d, w_group).reshape(B, S, MIX_W)
    return (y * scale).astype(a.dtype)


def rwkv7_mixer(xb, mu, w0, w2, a0, a2, g2, k_k, k_a, r_k, ln_w, ln_b):
    B, S, _ = xb.shape
    f32 = jnp.float32
    xb = xb + mu * (shift_right(xb) - xb)
    r, k, v, lw, la, lg = jnp.split(xb, RWKV_SPLITS, axis=-1)
    w = -jax.nn.softplus(-(w0 + jnp.tanh(lw) @ w2).astype(f32)) - 0.5
    decay = jnp.exp(-jnp.exp(w))
    a = jax.nn.sigmoid((a0 + la @ a2).astype(f32))
    g = jax.nn.sigmoid(lg) @ g2
    hd = lambda t: t.reshape(B, S, RWKV_HEADS, RWKV_HEAD)
    kk = hd((k * k_k).astype(f32))
    kk = kk / jnp.maximum(jnp.linalg.norm(kk, axis=-1, keepdims=True), 1e-12)
    k = k.astype(f32) * (1 + (a - 1) * k_a)
    r4, k4, v4, a4, w4 = hd(r.astype(f32)), hd(k), hd(v.astype(f32)), hd(a), hd(decay)

    def step(state, inp):
        r_t, w_t, k_t, v_t, kk_t, a_t = inp
        sa = jnp.einsum('bhvk,bhk->bhv', state, -kk_t)
        state = (state * w_t[:, :, None, :] + sa[..., None] * (kk_t * a_t)[:, :, None, :]
                 + v_t[..., None] * k_t[:, :, None, :])
        return state, jnp.einsum('bhvk,bhk->bhv', state, r_t)

    tm = lambda t: jnp.moveaxis(t, 1, 0)
    s0 = jnp.zeros((B, RWKV_HEADS, RWKV_HEAD, RWKV_HEAD), f32)
    _, y = lax.scan(step, s0, (tm(r4), tm(w4), tm(k4), tm(v4), tm(kk), tm(a4)))
    y = jnp.moveaxis(y, 0, 1)
    mean = jnp.mean(y, axis=-1, keepdims=True)
    var = jnp.var(y, axis=-1, keepdims=True)
    y = ((y - mean) * lax.rsqrt(var + RWKV_LN_EPS)).reshape(B, S, MIX_W) * ln_w + ln_b
    bonus = jnp.sum(r4 * k4 * r_k, axis=-1, keepdims=True) * v4
    y = y + bonus.reshape(B, S, MIX_W)
    return (y * g).astype(xb.dtype)


def spatial_gating_mixer(xc, ln_w, ln_b, w_s, b_s):
    B, S, _ = xc.shape
    z = jax.nn.gelu(xc)
    u, v = jnp.split(z, 2, axis=-1)
    v32 = v.astype(jnp.float32)
    mean = jnp.mean(v32, axis=-1, keepdims=True)
    var = jnp.var(v32, axis=-1, keepdims=True)
    v = ((v32 - mean) * lax.rsqrt(var + SG_LN_EPS) * ln_w + ln_b).astype(xc.dtype)
    mask = jnp.tril(jnp.ones((SG_CHUNK, SG_CHUNK), dtype=bool))
    w_m = jnp.where(mask, w_s, 0)
    vc = v.reshape(B, S // SG_CHUNK, SG_CHUNK, SG_GROUPS, SG_GROUP_W)
    mixed = jnp.einsum('gts,bnsgc->bntgc', w_m, vc) + jnp.swapaxes(b_s, 0, 1)[None, None, :, :, None]
    return (u * mixed.reshape(B, S, MIX_W)).astype(xc.dtype)


def hgrn2_mixer(xd, lb, norm_w):
    B, S, _ = xd.shape
    f32 = jnp.float32
    q, f, i = jnp.split(xd, 3, axis=-1)
    q = jax.nn.silu(q.astype(f32))
    f = f.astype(f32)
    lb = lb.astype(f32)
    sig = jax.nn.sigmoid(f)
    log_g = jnp.log(jnp.maximum(lb + (1 - lb) * sig, GATE_FLOOR))
    key = (1 - lb) * (1 - sig)
    NC = S // HGRN_CHUNK
    ch = lambda t: t.reshape(B, NC, HGRN_CHUNK, HGRN_HEADS, HGRN_EXPAND).transpose(1, 0, 3, 2, 4)
    mask = jnp.tril(jnp.ones((HGRN_CHUNK, HGRN_CHUNK), dtype=bool))[:, :, None]

    def chunk_step(state, inp):
        q_c, k_c, v_c, lg_c = inp
        cum = jnp.cumsum(lg_c, axis=2)
        o_inter = jnp.einsum('bhtk,bhkv->bhtv', q_c * jnp.exp(cum), state)
        rel = cum[:, :, :, None, :] - cum[:, :, None, :, :]
        dec = jnp.where(mask, jnp.exp(jnp.where(mask, rel, 0.0)), 0.0)
        scores = jnp.einsum('bhtk,bhtsk,bhsk->bhts', q_c, dec, k_c)
        o_intra = jnp.einsum('bhts,bhsv->bhtv', scores, v_c)
        last = cum[:, :, -1:, :]
        state = (jnp.exp(last[:, :, 0, :, None]) * state
                 + jnp.einsum('bhsk,bhsv->bhkv', k_c * jnp.exp(last - cum), v_c))
        return state, o_inter + o_intra

    s0 = jnp.zeros((B, HGRN_HEADS, HGRN_EXPAND, HGRN_EXPAND), f32)
    _, o = lax.scan(chunk_step, s0, (ch(q), ch(key), ch(i.astype(f32)), ch(log_g)))
    o = o.transpose(1, 0, 3, 2, 4).reshape(B, S, HGRN_HEADS, HGRN_EXPAND)
    o = o * lax.rsqrt(jnp.mean(o * o, axis=-1, keepdims=True) + NORM_EPS)
    return (o.reshape(B, S, MIX_W) * norm_w).astype(xd.dtype)


def conv_glu_ffn(h, w_up, conv_w, conv_b, w_down):
    u = h @ w_up
    u = conv_b + sum(conv_w[CONV_W - 1 - j] * shift_right(u, j) for j in range(CONV_W))
    gate, val = jnp.split(u, 2, axis=-1)
    return (jax.nn.gelu(gate) * val) @ w_down


def setup_inputs(seed: int = 0) -> dict:
    key = jax.random.key(seed)
    ks = iter(jax.random.split(key, 40))
    nrm = lambda shape, s: jax.random.normal(next(ks), shape, jnp.float32) * s
    gain = lambda shape: 1.0 + nrm(shape, 0.02)
    L = DEPTH
    return {
        "x": nrm((BATCH, SEQ, D_MODEL), 1.0),
        "p": nrm((L, BATCH, SEQ, PLE_DIM), 1.0),
        "norm_mix": gain((L, D_MODEL)),
        "w_in": nrm((L, D_MODEL, D_IN), D_MODEL ** -0.5),
        "pool_w": nrm((L, len(POOL_WINDOWS), POOL_GROUP, POOL_GROUP), POOL_GROUP ** -0.5),
        "pool_scale": gain((L, MIX_W)),
        "rwkv_mu": jax.random.uniform(next(ks), (L, RWKV_IN), jnp.float32),
        "rwkv_w0": jax.random.uniform(next(ks), (L, MIX_W), jnp.float32, -6.0, -1.0),
        "rwkv_w2": nrm((L, RWKV_DECAY_RANK, MIX_W), 0.1 * RWKV_DECAY_RANK ** -0.5),
        "rwkv_a0": nrm((L, MIX_W), 0.1),
        "rwkv_a2": nrm((L, RWKV_A_RANK, MIX_W), RWKV_A_RANK ** -0.5),
        "rwkv_g2": nrm((L, RWKV_G_RANK, MIX_W), RWKV_G_RANK ** -0.5),
        "rwkv_kk": 0.85 + nrm((L, MIX_W), 0.02),
        "rwkv_ka": gain((L, MIX_W)),
        "rwkv_rk": nrm((L, RWKV_HEADS, RWKV_HEAD), 0.1),
        "rwkv_ln_w": gain((L, MIX_W)),
        "rwkv_ln_b": nrm((L, MIX_W), 0.02),
        "sg_ln_w": gain((L, MIX_W)),
        "sg_ln_b": nrm((L, MIX_W), 0.02),
        "sg_w": nrm((L, SG_GROUPS, SG_CHUNK, SG_CHUNK), SG_CHUNK ** -0.5),
        "sg_b": gain((L, SG_GROUPS, SG_CHUNK)),
        "hgrn_lb": nrm((L, MIX_W), 0.5),
        "hgrn_norm": gain((L, MIX_W)),
        "w_branch": nrm((L, N_BRANCH, MIX_W, D_MODEL), MIX_W ** -0.5),
        "w_out": nrm((L, D_MODEL, D_MODEL), D_MODEL ** -0.5),
        "norm_ffn": gain((L, D_MODEL)),
        "ffn_up": nrm((L, D_MODEL, 2 * D_FF), D_MODEL ** -0.5),
        "ffn_conv": nrm((L, CONV_W, 2 * D_FF), CONV_W ** -0.5),
        "ffn_conv_b": nrm((L, 2 * D_FF), 0.02),
        "ffn_down": nrm((L, D_FF, D_MODEL), D_FF ** -0.5),
        "norm_ple": gain((L, D_MODEL)),
        "ple_proj": nrm((L, PLE_DIM, D_MODEL), PLE_DIM ** -0.5),
        "ple_gate": nrm((L, D_MODEL, D_MODEL), D_MODEL ** -0.5),
        "norm_final": gain((D_MODEL,)),
    }


def reference(x, p, norm_mix, w_in, pool_w, pool_scale, rwkv_mu, rwkv_w0, rwkv_w2, rwkv_a0, rwkv_a2,
              rwkv_g2, rwkv_kk, rwkv_ka, rwkv_rk, rwkv_ln_w, rwkv_ln_b, sg_ln_w, sg_ln_b, sg_w, sg_b,
              hgrn_lb, hgrn_norm, w_branch, w_out, norm_ffn, ffn_up, ffn_conv, ffn_conv_b, ffn_down,
              norm_ple, ple_proj, ple_gate, norm_final):
    B, S, _ = x.shape
    probs = jax.nn.softmax(hgrn_lb.astype(jnp.float32), axis=0)
    lower_bounds = jnp.cumsum(probs, axis=0) - probs[0]
    for l in range(DEPTH):
        h = rmsnorm(x, norm_mix[l])
        proj = h @ w_in[l]
        xa, xb, xc, xd, g = jnp.split(proj, IN_SPLITS, axis=-1)
        branches = (
            pool_mixer(xa, pool_w[l], pool_scale[l]),
            rwkv7_mixer(xb, rwkv_mu[l], rwkv_w0[l], rwkv_w2[l], rwkv_a0[l], rwkv_a2[l], rwkv_g2[l],
                        rwkv_kk[l], rwkv_ka[l], rwkv_rk[l], rwkv_ln_w[l], rwkv_ln_b[l]),
            spatial_gating_mixer(xc, sg_ln_w[l], sg_ln_b[l], sg_w[l], sg_b[l]),
            hgrn2_mixer(xd, lower_bounds[l], hgrn_norm[l]),
        )
        gates = jax.nn.sigmoid(g.reshape(B, S, N_BRANCH, D_MODEL))
        merged = sum(gates[:, :, k] * (branches[k] @ w_branch[l, k]) for k in range(N_BRANCH))
        x = x + merged @ w_out[l]
        x = x + conv_glu_ffn(rmsnorm(x, norm_ffn[l]), ffn_up[l], ffn_conv[l], ffn_conv_b[l], ffn_down[l])
        x = x + (p[l] @ ple_proj[l]) * jax.nn.sigmoid(rmsnorm(x, norm_ple[l]) @ ple_gate[l])
    return rmsnorm(x, norm_final)
```

```cpp
#include <hip/hip_runtime.h>
#include <hip/hip_cooperative_groups.h>
#include <cstdio>
namespace cg = cooperative_groups;

#define PG8_LAS __attribute__((address_space(3)))
typedef unsigned short bf16_t;
typedef short bf16x8 __attribute__((ext_vector_type(8)));
typedef float f32x4 __attribute__((ext_vector_type(4)));
typedef float f32x2 __attribute__((ext_vector_type(2)));
typedef unsigned u32x4 __attribute__((ext_vector_type(4)));
typedef unsigned u32x2 __attribute__((ext_vector_type(2)));
constexpr int BM = 256, BK = 64, HALF = 128, HTB = HALF * BK * 2, STAGE_BYTES = 8 * HTB, NXCD = 8, WGM = 8;

__host__ __device__ __forceinline__ int lds_byte(int r, int c) { const int st = (r >> 4) * 2 + (c >> 5), rr = r & 15, cc = c & 31, ob = rr * 64 + cc * 2; return st * 1024 + (ob ^ (((ob >> 9) & 1) << 5)); }
__host__ __device__ __forceinline__ void stage_rc(int b, int& R, int& C) { const int st = b / 1024, sb = b % 1024, swz = sb ^ (((sb >> 9) & 1) << 5); R = (st >> 1) * 16 + swz / 64; C = (st & 1) * 32 + (swz % 64) / 2; }
__host__ __device__ __forceinline__ int perm32(int rho) { const int n = rho >> 4, i = rho & 15; return 8 * (i >> 2) + 4 * n + (i & 3); }

__device__ __forceinline__ int tid_v() { int t = threadIdx.x; asm volatile("" : "+v"(t)); return t; }
__device__ __forceinline__ int bid_s() { int b = blockIdx.x; asm volatile("" : "+s"(b)); return b; }
struct Unit { int pm, pn; };
struct Gemm { const bf16_t* A; const bf16_t* Bt; int M, N, K; };

struct StaticOrder {
    int nM, nN, nwg, G, c;
    __host__ __device__ void init(int M, int N, int G_, int c_) { nM = M / BM; nN = N / BM; nwg = nM * nN; G = G_; c = c_; }
    __host__ __device__ bool next(int i, Unit& u) const {
        const long L = (long)i * G + c; if (L >= nwg) return false;
        int wgid = (int)L; { const int q = nwg / NXCD, r = nwg % NXCD, xcd = wgid % NXCD, off = wgid / NXCD; wgid = (xcd < r ? xcd * (q + 1) : r * (q + 1) + (xcd - r) * q) + off; }
        const int nig = WGM * nN, gid = wgid / nig, fm = gid * WGM, gsz = (nM - fm) < WGM ? (nM - fm) : WGM;
        u.pm = fm + ((wgid % nig) % gsz); u.pn = (wgid % nig) / gsz; return true;
    }
    __device__ __forceinline__ void a_ready(const Unit&) const {}
    __device__ __forceinline__ void done(const Unit&) const {}
};

typedef __bf16 bf16x2_t __attribute__((ext_vector_type(2)));
__device__ __forceinline__ unsigned cvt_pk_bf16(float lo, float hi) { const f32x2 v = {lo, hi}; return __builtin_bit_cast(unsigned, __builtin_convertvector(v, bf16x2_t)); }
__device__ __forceinline__ float bf2f(bf16_t b) { return __uint_as_float(((unsigned)b) << 16); }
__device__ __forceinline__ float bflo(unsigned w) { return __uint_as_float(w << 16); }
__device__ __forceinline__ float bfhi(unsigned w) { return __uint_as_float(w & 0xffff0000u); }
__device__ __forceinline__ bf16_t f2bf(float f) { unsigned u = __float_as_uint(f); u += 0x7FFFu + ((u >> 16) & 1u); return (bf16_t)(u >> 16); }
__device__ __forceinline__ float sigm(float x) { return __builtin_amdgcn_rcpf(1.0f + __expf(-x)); }
__device__ __forceinline__ float gelu_t(float x) { return x * __builtin_amdgcn_rcpf(1.0f + __expf(-1.5957691216f * (x + 0.044715f * x * x * x))); }
__device__ __forceinline__ float silu_f(float x) { return x * __builtin_amdgcn_rcpf(1.0f + __expf(-x)); }
__device__ __forceinline__ float wsum(float v) {
#pragma unroll
    for (int o = 32; o; o >>= 1) v += __shfl_xor(v, o);
    return v;
}
template <int CTRL> __device__ __forceinline__ float dppf(float v) { return __int_as_float(__builtin_amdgcn_update_dpp(0, __float_as_int(v), CTRL, 0xf, 0xf, true)); }
__device__ __forceinline__ float rsum16(float v) {
    v += dppf<0xB1>(v); v += dppf<0x4E>(v); v += dppf<0x141>(v); v += dppf<0x140>(v); return v;
}

__device__ __forceinline__ u32x4 pack8(const f32x4& v0, const f32x4& v1) { u32x4 w; w.x = cvt_pk_bf16(v0[0], v0[1]); w.y = cvt_pk_bf16(v0[2], v0[3]); w.z = cvt_pk_bf16(v1[0], v1[1]); w.w = cvt_pk_bf16(v1[2], v1[3]); return w; }
__device__ __forceinline__ void unpack8(const u32x4& w, f32x4& v0, f32x4& v1) { v0[0] = bflo(w.x); v0[1] = bfhi(w.x); v0[2] = bflo(w.y); v0[3] = bfhi(w.y); v1[0] = bflo(w.z); v1[1] = bfhi(w.z); v1[2] = bflo(w.w); v1[3] = bfhi(w.w); }

struct EpiProj {
    static constexpr bool PERM = true, AFTER_DRAIN = false;
    const float* ss; bf16_t* bA; bf16_t* bB; bf16_t* bC; bf16_t* bD;
    __device__ __forceinline__ void operator()(const f32x4 (&acc)[2][2][4][2], const Unit& u, int wr, int wc, int fr, int fq) const {
        const int pn = u.pn; bf16_t* base; int ld, coff, act;
        if (pn < 2) { base = bA; ld = 512; coff = pn * 256; act = 0; }
        else if (pn < 9) { base = bB; ld = 1792; coff = (pn - 2) * 256; act = 0; }
        else if (pn < 13) { base = bC; ld = 1024; coff = (pn - 9) * 256; act = 1; }
        else { base = bD; ld = 1536; coff = (pn - 13) * 256; act = pn < 15 ? 2 : (pn < 17 ? 4 : 0); }
        const int row0 = u.pm * BM + wr * 64 + fr, col0 = coff + wc * 32 + 8 * fq;
#pragma unroll
        for (int ai = 0; ai < 2; ++ai)
#pragma unroll
            for (int m = 0; m < 4; ++m) {
                const int row = row0 + ai * HALF + m * 16;
                bf16_t* rowp = base + (size_t)row * ld + col0;
#pragma unroll
                for (int bj = 0; bj < 2; ++bj) {
                    f32x4 v0 = acc[ai][bj][m][0], v1 = acc[ai][bj][m][1];
                    if (act == 1) {
#pragma unroll
                        for (int j = 0; j < 4; ++j) { v0[j] = gelu_t(v0[j]); v1[j] = gelu_t(v1[j]); }
                    } else if (act == 2) {
#pragma unroll
                        for (int j = 0; j < 4; ++j) { v0[j] = silu_f(v0[j]); v1[j] = silu_f(v1[j]); }
                    } else if (act == 4) {
#pragma unroll
                        for (int j = 0; j < 4; ++j) { v0[j] = sigm(-v0[j]); v1[j] = sigm(-v1[j]); }
                    }
                    *(u32x4*)(rowp + bj * HALF) = pack8(v0, v1);
                }
            }
    }
};

template <int ACT  > struct EpiBf {
    static constexpr bool PERM = true, AFTER_DRAIN = false;
    const float* ss; bf16_t* out; int ld;
    __device__ __forceinline__ void operator()(const f32x4 (&acc)[2][2][4][2], const Unit& u, int wr, int wc, int fr, int fq) const {
        const int row0 = u.pm * BM + wr * 64 + fr, col0 = u.pn * BM + wc * 32 + 8 * fq;
#pragma unroll
        for (int ai = 0; ai < 2; ++ai)
#pragma unroll
            for (int m = 0; m < 4; ++m) {
                const int row = row0 + ai * HALF + m * 16;
                const float rs = ss ? rsqrtf(ss[row] * (1.0f / 1024.0f) + 1e-6f) : 1.0f;
                bf16_t* rowp = out + (size_t)row * ld + col0;
#pragma unroll
                for (int bj = 0; bj < 2; ++bj) {
                    f32x4 v0 = acc[ai][bj][m][0] * rs, v1 = acc[ai][bj][m][1] * rs;
                    if (ACT == 3) {
#pragma unroll
                        for (int j = 0; j < 4; ++j) { v0[j] = sigm(v0[j]); v1[j] = sigm(v1[j]); }
                    }
                    *(u32x4*)(rowp + bj * HALF) = pack8(v0, v1);
                }
            }
    }
};

struct EpiBranch {
    static constexpr bool PERM = true, AFTER_DRAIN = false;
    const bf16_t* gates; float* mrg; bf16_t* mb; int kb;
    __device__ __forceinline__ void operator()(const f32x4 (&acc)[2][2][4][2], const Unit& u, int wr, int wc, int fr, int fq) const {
        const int row0 = u.pm * BM + wr * 64 + fr, col0 = u.pn * BM + wc * 32 + 8 * fq;
#pragma unroll
        for (int ai = 0; ai < 2; ++ai)
#pragma unroll
            for (int m = 0; m < 4; ++m) {
                const int row = row0 + ai * HALF + m * 16;
#pragma unroll
                for (int bj = 0; bj < 2; ++bj) {
                    const size_t idx = (size_t)row * 1024 + col0 + bj * HALF;
                    const u32x4 gw = *(const u32x4*)(gates + idx);
                    f32x4 g0, g1; unpack8(gw, g0, g1);
                    f32x4 m0 = {0.f, 0.f, 0.f, 0.f}, m1 = {0.f, 0.f, 0.f, 0.f};
                    if (kb > 0) { m0 = *(const f32x4*)(mrg + idx); m1 = *(const f32x4*)(mrg + idx + 4); }
                    m0 += g0 * acc[ai][bj][m][0]; m1 += g1 * acc[ai][bj][m][1];
                    if (kb < 3) { *(f32x4*)(mrg + idx) = m0; *(f32x4*)(mrg + idx + 4) = m1; }
                    else *(u32x4*)(mb + idx) = pack8(m0, m1);
                }
            }
    }
};

struct EpiRes {
    static constexpr bool PERM = true, AFTER_DRAIN = false;
    const float* xin; float* xout; bf16_t* xb; float* ssn; int s;
    __device__ __forceinline__ void operator()(const f32x4 (&acc)[2][2][4][2], const Unit& u, int wr, int wc, int fr, int fq) const {
        const int row0 = u.pm * BM + wr * 64 + fr, col0 = u.pn * BM + wc * 32 + 8 * fq;
#pragma unroll
        for (int ai = 0; ai < 2; ++ai)
#pragma unroll
            for (int m = 0; m < 4; ++m) {
                const int row = row0 + ai * HALF + m * 16;
                const size_t rowg = (size_t)((row >> 11) * 4096 + s * 2048 + (row & 2047));
                float sq = 0.f;
#pragma unroll
                for (int bj = 0; bj < 2; ++bj) {
                    const size_t gi = rowg * 1024 + col0 + bj * HALF;
                    f32x4 x0 = *(const f32x4*)(xin + gi), x1 = *(const f32x4*)(xin + gi + 4);
                    x0 += acc[ai][bj][m][0]; x1 += acc[ai][bj][m][1];
                    *(f32x4*)(xout + gi) = x0; *(f32x4*)(xout + gi + 4) = x1;
                    *(u32x4*)(xb + (size_t)row * 1024 + col0 + bj * HALF) = pack8(x0, x1);
                    sq += x0[0] * x0[0] + x0[1] * x0[1] + x0[2] * x0[2] + x0[3] * x0[3] + x1[0] * x1[0] + x1[1] * x1[1] + x1[2] * x1[2] + x1[3] * x1[3];
                }
                sq += __shfl_xor(sq, 16); sq += __shfl_xor(sq, 32);
                if (fq == 0) atomicAdd(ssn + row, sq);
            }
    }
};

struct EpiPle {
    static constexpr bool PERM = true, AFTER_DRAIN = false;
    const float* ss; const bf16_t* pp; float* x; int s;
    __device__ __forceinline__ void operator()(const f32x4 (&acc)[2][2][4][2], const Unit& u, int wr, int wc, int fr, int fq) const {
        const int row0 = u.pm * BM + wr * 64 + fr, col0 = u.pn * BM + wc * 32 + 8 * fq;
#pragma unroll
        for (int ai = 0; ai < 2; ++ai)
#pragma unroll
            for (int m = 0; m < 4; ++m) {
                const int row = row0 + ai * HALF + m * 16;
                const size_t rowg = (size_t)((row >> 11) * 4096 + s * 2048 + (row & 2047));
                const float rs = rsqrtf(ss[row] * (1.0f / 1024.0f) + 1e-6f);
#pragma unroll
                for (int bj = 0; bj < 2; ++bj) {
                    const size_t gi = rowg * 1024 + col0 + bj * HALF;
                    const u32x4 pw = *(const u32x4*)(pp + (size_t)row * 1024 + col0 + bj * HALF);
                    f32x4 p0, p1; unpack8(pw, p0, p1);
                    f32x4 x0 = *(const f32x4*)(x + gi), x1 = *(const f32x4*)(x + gi + 4);
#pragma unroll
                    for (int j = 0; j < 4; ++j) { x0[j] += p0[j] * sigm(acc[ai][bj][m][0][j] * rs); x1[j] += p1[j] * sigm(acc[ai][bj][m][1][j] * rs); }
                    *(f32x4*)(x + gi) = x0; *(f32x4*)(x + gi + 4) = x1;
                }
            }
    }
};

struct UnitX { int pm, pn; const bf16_t* A; const bf16_t* Bt; int K; int kind; int kb; };
template <class Epi, class Sched>
__device__ __forceinline__ void gemm_phase(PG8_LAS unsigned char* lds, const Gemm g, const Sched& S, const Epi& E) {
    const int tid = tid_v(), wid = __builtin_amdgcn_readfirstlane(tid >> 6), lane = tid & 63, wr = wid >> 2, wc = wid & 3, fr = lane & 15, fq = lane >> 4;
    const int K = g.K, nt = K / BK;
    unsigned voffA[2], voffB[2];
#pragma unroll
    for (int i = 0; i < 2; ++i) { int R, C; stage_rc(tid * 16 + i * 8192, R, C); const int Rb = Epi::PERM ? ((R & ~31) + perm32(R & 31)) : R;
        voffA[i] = (unsigned)(R * K + C) * 2u; voffB[i] = (unsigned)(Rb * K + C) * 2u; }
    const size_t kstep = (size_t)(BK * 2);
    const size_t hstep = (size_t)HALF * K * 2;
    const size_t tstep = 2 * hstep;
    const unsigned ldsw = (unsigned)wid * 1024u;
    const int aoff = lds_byte(wr * 64 + fr, fq * 8), boff = lds_byte(wc * 32 + fr, fq * 8);
#define PG8_SA(b, h) (((b) * 2 + (h)) * HTB)
#define PG8_SB(b, h) ((4 + (b) * 2 + (h)) * HTB)
#define PG8_STAGE(bufoff, gbase, voff) do { _Pragma("unroll") for (int _i = 0; _i < 2; ++_i) \
        __builtin_amdgcn_global_load_lds((const unsigned*)((const char*)(gbase) + (voff)[_i]), (PG8_LAS unsigned*)(lds + (bufoff) + ldsw + _i * 8192), 16, 0, 0); } while (0)
#define PG8_LDA(dst, b, h) do { _Pragma("unroll") for (int m = 0; m < 4; ++m) _Pragma("unroll") for (int k = 0; k < 2; ++k) dst[m][k] = *(const PG8_LAS bf16x8*)(lds + PG8_SA(b, h) + aoff + m * 2048 + k * 1024); } while (0)
#define PG8_LDB(dst, b, h) do { _Pragma("unroll") for (int n = 0; n < 2; ++n) _Pragma("unroll") for (int k = 0; k < 2; ++k) dst[n][k] = *(const PG8_LAS bf16x8*)(lds + PG8_SB(b, h) + boff + n * 2048 + k * 1024); } while (0)
#define PG8_MMA(ai, bj, At, Bt) do { __builtin_amdgcn_s_setprio(1); _Pragma("unroll") for (int m = 0; m < 4; ++m) _Pragma("unroll") for (int n = 0; n < 2; ++n) _Pragma("unroll") for (int k = 0; k < 2; ++k) \
        acc[ai][bj][m][n] = __builtin_amdgcn_mfma_f32_16x16x32_bf16(Bt[n][k], At[m][k], acc[ai][bj][m][n], 0, 0, 0); __builtin_amdgcn_s_setprio(0); } while (0)
#define PG8_WAIT_V(n) asm volatile("s_waitcnt vmcnt(" #n ")" ::: "memory")
#define PG8_WAIT_L(n) asm volatile("s_waitcnt lgkmcnt(" #n ")" ::: "memory")
#define PG8_BAR __builtin_amdgcn_s_barrier()
#define PG8_SCHED __builtin_amdgcn_sched_barrier(0)
    Unit cur, nxt; int ui = 0;
    if (!S.next(0, cur)) return;
    f32x4 acc[2][2][4][2];
#pragma unroll
    for (int a = 0; a < 2; ++a)
#pragma unroll
        for (int b = 0; b < 2; ++b)
#pragma unroll
            for (int m = 0; m < 4; ++m)
#pragma unroll
                for (int n = 0; n < 2; ++n) acc[a][b][m][n] = (f32x4){0.f, 0.f, 0.f, 0.f};
    bf16x8 At[4][2], B0[2][2], B1[2][2];
    const char* cA = (const char*)g.A + (size_t)cur.pm * tstep; const char* cB = (const char*)g.Bt + (size_t)cur.pn * tstep;
    S.a_ready(cur);
    PG8_STAGE(PG8_SB(0, 0), cB, voffB); PG8_STAGE(PG8_SA(0, 0), cA, voffA); PG8_STAGE(PG8_SB(0, 1), cB + hstep, voffB); PG8_STAGE(PG8_SA(0, 1), cA + hstep, voffA);
    if (wr == 1) PG8_BAR;
    PG8_WAIT_V(4); PG8_BAR;
    PG8_STAGE(PG8_SB(1, 0), cB + kstep, voffB); PG8_STAGE(PG8_SA(1, 0), cA + kstep, voffA); PG8_STAGE(PG8_SB(1, 1), cB + hstep + kstep, voffB);
    PG8_WAIT_V(6); PG8_BAR;
    for (;;) {
        const bool has_next = S.next(ui + 1, nxt);
        const char* nA = has_next ? (const char*)g.A + (size_t)nxt.pm * tstep : cA; const char* nB = has_next ? (const char*)g.Bt + (size_t)nxt.pn * tstep : cB;
        for (int t = 0; t < nt; t += 2) {
            const bool last = (t == nt - 2);
            const char* a1 = cA + (size_t)(t + 1) * kstep;
            const char* a2 = last ? nA : cA + (size_t)(t + 2) * kstep; const char* b2 = last ? nB : cB + (size_t)(t + 2) * kstep;
            const char* a3 = a2 + kstep; const char* b3 = b2 + kstep;
            if (last && has_next) S.a_ready(nxt);
            PG8_LDB(B0, 0, 0); PG8_SCHED; PG8_LDA(At, 0, 0); PG8_STAGE(PG8_SA(1, 1), a1 + hstep, voffA);
            PG8_WAIT_L(8); PG8_BAR; PG8_WAIT_L(0); PG8_MMA(0, 0, At, B0); PG8_BAR; PG8_SCHED;
            PG8_LDB(B1, 0, 1); PG8_STAGE(PG8_SB(0, 0), b2, voffB);
            PG8_BAR; PG8_WAIT_L(0); PG8_MMA(0, 1, At, B1); PG8_BAR;
            PG8_LDA(At, 0, 1); PG8_STAGE(PG8_SA(0, 0), a2, voffA);
            PG8_BAR; PG8_WAIT_L(0); PG8_MMA(1, 0, At, B0); PG8_BAR; PG8_SCHED;
            PG8_STAGE(PG8_SB(0, 1), b2 + hstep, voffB);
            PG8_WAIT_V(6); PG8_BAR; PG8_MMA(1, 1, At, B1); PG8_BAR;
            PG8_LDB(B0, 1, 0); PG8_SCHED; PG8_LDA(At, 1, 0); PG8_STAGE(PG8_SA(0, 1), a2 + hstep, voffA);
            PG8_WAIT_L(8); PG8_BAR; PG8_WAIT_L(0); PG8_MMA(0, 0, At, B0); PG8_BAR; PG8_SCHED;
            PG8_LDB(B1, 1, 1); PG8_STAGE(PG8_SB(1, 0), b3, voffB);
            PG8_BAR; PG8_WAIT_L(0); PG8_MMA(0, 1, At, B1); PG8_BAR;
            PG8_LDA(At, 1, 1); PG8_STAGE(PG8_SA(1, 0), a3, voffA);
            PG8_BAR; PG8_WAIT_L(0); PG8_MMA(1, 0, At, B0); PG8_BAR; PG8_SCHED;
            PG8_STAGE(PG8_SB(1, 1), b3 + hstep, voffB);
            PG8_WAIT_V(6); PG8_BAR; PG8_MMA(1, 1, At, B1); PG8_BAR;
        }
        if constexpr (!Epi::AFTER_DRAIN) { E(acc, cur, wr, wc, fr, fq); S.done(cur); }
        if (!has_next) break;
#pragma unroll
        for (int a = 0; a < 2; ++a)
#pragma unroll
            for (int b = 0; b < 2; ++b)
#pragma unroll
                for (int m = 0; m < 4; ++m)
#pragma unroll
                    for (int n = 0; n < 2; ++n) acc[a][b][m][n] = (f32x4){0.f, 0.f, 0.f, 0.f};
        cur = nxt; cA = nA; cB = nB; ++ui;
    }
    PG8_WAIT_V(0);
    if (wr == 0) PG8_BAR;
    PG8_BAR;
    if constexpr (Epi::AFTER_DRAIN) { E.fused(acc, cur, wr, wc, fr, fq, lds, wid, lane); S.done(cur); }
#undef PG8_SA
#undef PG8_SB
#undef PG8_STAGE
#undef PG8_LDA
#undef PG8_LDB
#undef PG8_MMA
#undef PG8_WAIT_V
#undef PG8_WAIT_L
#undef PG8_BAR
#undef PG8_SCHED
}

template <class Epi, class Sched>
__device__ __forceinline__ void gemm_phase_x(PG8_LAS unsigned char* lds, const Sched& S, const Epi& E) {
    const int tid = tid_v(), wid = __builtin_amdgcn_readfirstlane(tid >> 6), lane = tid & 63, wr = wid >> 2, wc = wid & 3, fr = lane & 15, fq = lane >> 4;
    UnitX cur, nxt; int ui = 0;
    if (!S.next(0, cur)) return;
    int K = cur.K, nt = K / BK;
    unsigned voffA[2], voffB[2], nvoffA[2], nvoffB[2];
#pragma unroll
    for (int i = 0; i < 2; ++i) { int R, C; stage_rc(tid * 16 + i * 8192, R, C); const int Rb = Epi::PERM ? ((R & ~31) + perm32(R & 31)) : R;
        voffA[i] = (unsigned)(R * K + C) * 2u; voffB[i] = (unsigned)(Rb * K + C) * 2u; }
    const size_t kstep = (size_t)(BK * 2);
    size_t hstep = (size_t)HALF * K * 2;
    size_t tstep = 2 * hstep;
    const unsigned ldsw = (unsigned)wid * 1024u;
    const int aoff = lds_byte(wr * 64 + fr, fq * 8), boff = lds_byte(wc * 32 + fr, fq * 8);
#define PG8_SA(b, h) (((b) * 2 + (h)) * HTB)
#define PG8_SB(b, h) ((4 + (b) * 2 + (h)) * HTB)
#define PG8_STAGE(bufoff, gbase, voff) do { _Pragma("unroll") for (int _i = 0; _i < 2; ++_i) \
        __builtin_amdgcn_global_load_lds((const unsigned*)((const char*)(gbase) + (voff)[_i]), (PG8_LAS unsigned*)(lds + (bufoff) + ldsw + _i * 8192), 16, 0, 0); } while (0)
#define PG8_LDA(dst, b, h) do { _Pragma("unroll") for (int m = 0; m < 4; ++m) _Pragma("unroll") for (int k = 0; k < 2; ++k) dst[m][k] = *(const PG8_LAS bf16x8*)(lds + PG8_SA(b, h) + aoff + m * 2048 + k * 1024); } while (0)
#define PG8_LDB(dst, b, h) do { _Pragma("unroll") for (int n = 0; n < 2; ++n) _Pragma("unroll") for (int k = 0; k < 2; ++k) dst[n][k] = *(const PG8_LAS bf16x8*)(lds + PG8_SB(b, h) + boff + n * 2048 + k * 1024); } while (0)
#define PG8_MMA(ai, bj, At, Bt) do { __builtin_amdgcn_s_setprio(1); _Pragma("unroll") for (int m = 0; m < 4; ++m) _Pragma("unroll") for (int n = 0; n < 2; ++n) _Pragma("unroll") for (int k = 0; k < 2; ++k) \
        acc[ai][bj][m][n] = __builtin_amdgcn_mfma_f32_16x16x32_bf16(Bt[n][k], At[m][k], acc[ai][bj][m][n], 0, 0, 0); __builtin_amdgcn_s_setprio(0); } while (0)
#define PG8_WAIT_V(n) asm volatile("s_waitcnt vmcnt(" #n ")" ::: "memory")
#define PG8_WAIT_L(n) asm volatile("s_waitcnt lgkmcnt(" #n ")" ::: "memory")
#define PG8_BAR __builtin_amdgcn_s_barrier()
#define PG8_SCHED __builtin_amdgcn_sched_barrier(0)
    f32x4 acc[2][2][4][2];
#pragma unroll
    for (int a = 0; a < 2; ++a)
#pragma unroll
        for (int b = 0; b < 2; ++b)
#pragma unroll
            for (int m = 0; m < 4; ++m)
#pragma unroll
                for (int n = 0; n < 2; ++n) acc[a][b][m][n] = (f32x4){0.f, 0.f, 0.f, 0.f};
    bf16x8 At[4][2], B0[2][2], B1[2][2];
    const char* cA = (const char*)cur.A + (size_t)cur.pm * tstep; const char* cB = (const char*)cur.Bt + (size_t)cur.pn * tstep;
    S.a_ready(cur);
    PG8_STAGE(PG8_SB(0, 0), cB, voffB); PG8_STAGE(PG8_SA(0, 0), cA, voffA); PG8_STAGE(PG8_SB(0, 1), cB + hstep, voffB); PG8_STAGE(PG8_SA(0, 1), cA + hstep, voffA);
    if (wr == 1) PG8_BAR;
    PG8_WAIT_V(4); PG8_BAR;
    PG8_STAGE(PG8_SB(1, 0), cB + kstep, voffB); PG8_STAGE(PG8_SA(1, 0), cA + kstep, voffA); PG8_STAGE(PG8_SB(1, 1), cB + hstep + kstep, voffB);
    PG8_WAIT_V(6); PG8_BAR;
    for (;;) {
        const bool has_next = S.next(ui + 1, nxt);
        const int nK = has_next ? nxt.K : K; const size_t nhstep = (size_t)HALF * nK * 2;
#pragma unroll
        for (int i = 0; i < 2; ++i) { int R, C; stage_rc(tid * 16 + i * 8192, R, C); const int Rb = Epi::PERM ? ((R & ~31) + perm32(R & 31)) : R;
            nvoffA[i] = (unsigned)(R * nK + C) * 2u; nvoffB[i] = (unsigned)(Rb * nK + C) * 2u; }
        const char* nA = has_next ? (const char*)nxt.A + (size_t)nxt.pm * (2 * nhstep) : cA; const char* nB = has_next ? (const char*)nxt.Bt + (size_t)nxt.pn * (2 * nhstep) : cB;
        for (int t = 0; t < nt; t += 2) {
            const bool last = (t == nt - 2);
            const char* a1 = cA + (size_t)(t + 1) * kstep;
            const char* a2 = last ? nA : cA + (size_t)(t + 2) * kstep; const char* b2 = last ? nB : cB + (size_t)(t + 2) * kstep;
            const char* a3 = a2 + kstep; const char* b3 = b2 + kstep;
            const size_t hs2 = last ? nhstep : hstep;
            if (last && has_next) S.a_ready(nxt);
            PG8_LDB(B0, 0, 0); PG8_SCHED; PG8_LDA(At, 0, 0); PG8_STAGE(PG8_SA(1, 1), a1 + hstep, voffA);
            if (last) {
#pragma unroll
                for (int i = 0; i < 2; ++i) { voffA[i] = nvoffA[i]; voffB[i] = nvoffB[i]; } }
            PG8_WAIT_L(8); PG8_BAR; PG8_WAIT_L(0); PG8_MMA(0, 0, At, B0); PG8_BAR; PG8_SCHED;
            PG8_LDB(B1, 0, 1); PG8_STAGE(PG8_SB(0, 0), b2, voffB);
            PG8_BAR; PG8_WAIT_L(0); PG8_MMA(0, 1, At, B1); PG8_BAR;
            PG8_LDA(At, 0, 1); PG8_STAGE(PG8_SA(0, 0), a2, voffA);
            PG8_BAR; PG8_WAIT_L(0); PG8_MMA(1, 0, At, B0); PG8_BAR; PG8_SCHED;
            PG8_STAGE(PG8_SB(0, 1), b2 + hs2, voffB);
            PG8_WAIT_V(6); PG8_BAR; PG8_MMA(1, 1, At, B1); PG8_BAR;
            PG8_LDB(B0, 1, 0); PG8_SCHED; PG8_LDA(At, 1, 0); PG8_STAGE(PG8_SA(0, 1), a2 + hs2, voffA);
            PG8_WAIT_L(8); PG8_BAR; PG8_WAIT_L(0); PG8_MMA(0, 0, At, B0); PG8_BAR; PG8_SCHED;
            PG8_LDB(B1, 1, 1); PG8_STAGE(PG8_SB(1, 0), b3, voffB);
            PG8_BAR; PG8_WAIT_L(0); PG8_MMA(0, 1, At, B1); PG8_BAR;
            PG8_LDA(At, 1, 1); PG8_STAGE(PG8_SA(1, 0), a3, voffA);
            PG8_BAR; PG8_WAIT_L(0); PG8_MMA(1, 0, At, B0); PG8_BAR; PG8_SCHED;
            PG8_STAGE(PG8_SB(1, 1), b3 + hs2, voffB);
            PG8_WAIT_V(6); PG8_BAR; PG8_MMA(1, 1, At, B1); PG8_BAR;
        }
        if constexpr (!Epi::AFTER_DRAIN) { E(acc, cur, wr, wc, fr, fq); S.done(cur); }
        if (!has_next) break;
#pragma unroll
        for (int a = 0; a < 2; ++a)
#pragma unroll
            for (int b = 0; b < 2; ++b)
#pragma unroll
                for (int m = 0; m < 4; ++m)
#pragma unroll
                    for (int n = 0; n < 2; ++n) acc[a][b][m][n] = (f32x4){0.f, 0.f, 0.f, 0.f};
        cur = nxt; cA = nA; cB = nB; ++ui; K = nK; nt = K / BK; hstep = nhstep; tstep = 2 * hstep;
    }
    PG8_WAIT_V(0);
    if (wr == 0) PG8_BAR;
    PG8_BAR;
    if constexpr (Epi::AFTER_DRAIN) { E.fused(acc, cur, wr, wc, fr, fq, lds, wid, lane); S.done(cur); }
#undef PG8_SA
#undef PG8_SB
#undef PG8_STAGE
#undef PG8_LDA
#undef PG8_LDB
#undef PG8_MMA
#undef PG8_WAIT_V
#undef PG8_WAIT_L
#undef PG8_BAR
#undef PG8_SCHED
}

struct P5Order {
    Unit t; const bf16_t* xb; const bf16_t* Wg; const bf16_t* br; const bf16_t* Wb; size_t brs;
    __device__ __forceinline__ bool next(int i, UnitX& u) const {
        if (i >= 8) return false;
        const int kb = i >> 1; u.pm = t.pm; u.pn = t.pn; u.kb = kb; u.kind = i & 1;
        if ((i & 1) == 0) { u.A = xb; u.Bt = Wg + (size_t)kb * 1024 * 1024; u.K = 1024; }
        else { u.A = br + (size_t)kb * brs; u.Bt = Wb + (size_t)kb * 1024 * 512; u.K = 512; }
        return true;
    }
    __device__ __forceinline__ void a_ready(const UnitX&) const {}
    __device__ __forceinline__ void done(const UnitX&) const {}
};
struct EpiP5 {
    static constexpr bool PERM = true, AFTER_DRAIN = false;
    const float* ss; bf16_t* gates; float* mrg; bf16_t* mb;
    __device__ __forceinline__ void operator()(const f32x4 (&acc)[2][2][4][2], const UnitX& u, int wr, int wc, int fr, int fq) const {
        const int row0 = u.pm * BM + wr * 64 + fr, col0 = u.pn * BM + wc * 32 + 8 * fq, kb = u.kb;
        if (u.kind == 0) {
#pragma unroll
            for (int ai = 0; ai < 2; ++ai)
#pragma unroll
                for (int m = 0; m < 4; ++m) {
                    const int row = row0 + ai * HALF + m * 16;
#pragma unroll
                    for (int bj = 0; bj < 2; ++bj) {
                        f32x4 v0 = acc[ai][bj][m][0], v1 = acc[ai][bj][m][1];
#pragma unroll
                        for (int j = 0; j < 4; ++j) { v0[j] = sigm(v0[j]); v1[j] = sigm(v1[j]); }
                        *(u32x4*)(gates + (size_t)row * 1024 + col0 + bj * HALF) = pack8(v0, v1);
                    }
                }
        } else {
#pragma unroll
            for (int ai = 0; ai < 2; ++ai)
#pragma unroll
                for (int m = 0; m < 4; ++m) {
                    const int row = row0 + ai * HALF + m * 16;
#pragma unroll
                    for (int bj = 0; bj < 2; ++bj) {
                        const size_t idx = (size_t)row * 1024 + col0 + bj * HALF;
                        f32x4 g0, g1; unpack8(*(const u32x4*)(gates + idx), g0, g1);
                        f32x4 m0 = {0.f, 0.f, 0.f, 0.f}, m1 = {0.f, 0.f, 0.f, 0.f};
                        if (kb > 0) { m0 = *(const f32x4*)(mrg + idx); m1 = *(const f32x4*)(mrg + idx + 4); }
                        m0 += g0 * acc[ai][bj][m][0]; m1 += g1 * acc[ai][bj][m][1];
                        if (kb < 3) { *(f32x4*)(mrg + idx) = m0; *(f32x4*)(mrg + idx + 4) = m1; }
                        else *(u32x4*)(mb + idx) = pack8(m0, m1);
                    }
                }
        }
    }
};
struct P10Order {
    Unit t; const bf16_t* pb; const bf16_t* Wp; const bf16_t* xb; const bf16_t* Wg;
    __device__ __forceinline__ bool next(int i, UnitX& u) const {
        if (i >= 2) return false;
        u.pm = t.pm; u.pn = t.pn; u.kb = 0; u.kind = i;
        if (i == 0) { u.A = pb; u.Bt = Wp; u.K = 256; } else { u.A = xb; u.Bt = Wg; u.K = 1024; }
        return true;
    }
    __device__ __forceinline__ void a_ready(const UnitX&) const {}
    __device__ __forceinline__ void done(const UnitX&) const {}
};
struct EpiP10 {
    static constexpr bool PERM = true, AFTER_DRAIN = false;
    const float* ss; bf16_t* pp; float* x; int s;
    __device__ __forceinline__ void operator()(const f32x4 (&acc)[2][2][4][2], const UnitX& u, int wr, int wc, int fr, int fq) const {
        const int row0 = u.pm * BM + wr * 64 + fr, col0 = u.pn * BM + wc * 32 + 8 * fq;
#pragma unroll
        for (int ai = 0; ai < 2; ++ai)
#pragma unroll
            for (int m = 0; m < 4; ++m) {
                const int row = row0 + ai * HALF + m * 16;
                if (u.kind == 0) {
#pragma unroll
                    for (int bj = 0; bj < 2; ++bj) *(u32x4*)(pp + (size_t)row * 1024 + col0 + bj * HALF) = pack8(acc[ai][bj][m][0], acc[ai][bj][m][1]);
                } else {
                    const size_t rowg = (size_t)((row >> 11) * 4096 + s * 2048 + (row & 2047));
                    const float rs = rsqrtf(ss[row] * (1.0f / 1024.0f) + 1e-6f);
#pragma unroll
                    for (int bj = 0; bj < 2; ++bj) {
                        const size_t gi = rowg * 1024 + col0 + bj * HALF;
                        f32x4 p0, p1; unpack8(*(const u32x4*)(pp + (size_t)row * 1024 + col0 + bj * HALF), p0, p1);
                        f32x4 x0 = *(const f32x4*)(x + gi), x1 = *(const f32x4*)(x + gi + 4);
#pragma unroll
                        for (int j = 0; j < 4; ++j) { x0[j] += p0[j] * sigm(acc[ai][bj][m][0][j] * rs); x1[j] += p1[j] * sigm(acc[ai][bj][m][1][j] * rs); }
                        *(f32x4*)(x + gi) = x0; *(f32x4*)(x + gi + 4) = x1;
                    }
                }
            }
    }
};

#define XB_TMO      128
#define XB_XCNT(j)  (256  + 64 * (j))
#define XB_XSUB(j)  (1280 + 64 * (j))
#define XB_XGEN(j)  (2304 + 64 * (j))
#define XB_TOP      3328
#define XB_TOPGEN   3392
#define XCD_BAR_WORDS 3456
#define XB_SPIN_CAP (1u << 18)
#define LAS PG8_LAS

__device__ __forceinline__ unsigned xb_ld(unsigned* p)              { return __hip_atomic_load(p, __ATOMIC_RELAXED, __HIP_MEMORY_SCOPE_AGENT); }
__device__ __forceinline__ unsigned xb_add(unsigned* p, unsigned v) { return __hip_atomic_fetch_add(p, v, __ATOMIC_RELAXED, __HIP_MEMORY_SCOPE_AGENT); }
__device__ __forceinline__ unsigned xb_xcc_id() { return (unsigned)__builtin_amdgcn_s_getreg((3 << 11) | 20) & 0xFu; }
#define XB_SPIN(cond, bar) do { unsigned _sp = 0; while (cond) { __builtin_amdgcn_s_sleep(1); \
    if ((++_sp & 255u) == 0u) { if (xb_ld(&(bar)[XB_TMO])) break; if (_sp > XB_SPIN_CAP) { atomicAdd(&(bar)[XB_TMO], 1u); break; } } } } while (0)

struct XcdBarrier {
    unsigned* bar; unsigned x;
    volatile LAS unsigned* st;
};

__device__ __forceinline__ XcdBarrier xcd_barrier_post(unsigned* bar, volatile LAS unsigned* st) {
    XcdBarrier b; b.bar = bar; b.x = xb_xcc_id(); b.st = st;
    if (threadIdx.x == 0) (void)xb_add(&bar[XB_XCNT(b.x)], 1u);
    return b;
}
__device__ __forceinline__ void xcd_barrier_complete(unsigned* bar, unsigned x, unsigned& nloc, unsigned& nx) {
    const unsigned G = gridDim.x * gridDim.y * gridDim.z;
    unsigned sum, cnt, mine, sp = 0u;
    for (;;) {
        sum = 0u; cnt = 0u; mine = 0u;
#pragma unroll
        for (unsigned j = 0; j < 16; ++j) { const unsigned c = xb_ld(&bar[XB_XCNT(j)]); sum += c; cnt += (c > 0u) ? 1u : 0u; mine = (j == x) ? c : mine; }
        if (sum == G) break;
        __builtin_amdgcn_s_sleep(1);
        if ((++sp & 255u) == 0u) { if (xb_ld(&bar[XB_TMO])) break; if (sp > XB_SPIN_CAP) { atomicAdd(&bar[XB_TMO], 1u); break; } }
    }
    nloc = mine > 0u ? mine : 1u; nx = cnt > 0u ? cnt : 1u;
}

__device__ __forceinline__ void xcd_barrier(const XcdBarrier& b) {
    asm volatile("s_waitcnt vmcnt(0)" ::: "memory");
    __syncthreads();
    if (threadIdx.x == 0) {
        unsigned* bar = b.bar;
        __builtin_amdgcn_s_waitcnt(0);
        unsigned nloc = b.st[0], nx = b.st[1];
        if (nloc == 0u) { xcd_barrier_complete(bar, b.x, nloc, nx); b.st[0] = nloc; b.st[1] = nx; }
        const unsigned old = xb_add(&bar[XB_XSUB(b.x)], 1u);
        const unsigned gen = old / nloc;
        if (old + 1u == (gen + 1u) * nloc) {
            __builtin_amdgcn_fence(__ATOMIC_RELEASE, "agent");
            asm volatile("s_waitcnt vmcnt(0)" ::: "memory");
            const unsigned og = xb_add(&bar[XB_TOP], 1u);
            const unsigned tg = og / nx;
            if (og + 1u == (tg + 1u) * nx) xb_add(&bar[XB_TOPGEN], 1u);
            else XB_SPIN(xb_ld(&bar[XB_TOPGEN]) == tg, bar);
            __builtin_amdgcn_fence(__ATOMIC_ACQUIRE, "agent");
            xb_add(&bar[XB_XGEN(b.x)], 1u);
            asm volatile("s_waitcnt vmcnt(0)" ::: "memory");
        } else {
            XB_SPIN(xb_ld(&bar[XB_XGEN(b.x)]) == gen, bar);
            __builtin_amdgcn_fence(__ATOMIC_ACQUIRE, "agent");
            asm volatile("s_waitcnt vmcnt(0)" ::: "memory");
        }
    }
    __syncthreads();
}


template <int OFF> __device__ __forceinline__ const float* karg_ptr() { const __attribute__((address_space(1))) float* r; asm volatile("s_load_dwordx2 %0, %1, %2\n\ts_waitcnt lgkmcnt(0)" : "=s"(r) : "s"(__builtin_amdgcn_kernarg_segment_ptr()), "n"(OFF) : "memory"); return (const float*)r; }
#define IN(i) (karg_ptr<(i) * 8>())
#define OUTP() ((float*)karg_ptr<34 * 8>())
#define WSP() ((unsigned char*)karg_ptr<35 * 8>())
template <class T> __device__ __forceinline__ T launder_s(T v) { asm volatile("" : "+s"(v)); return v; }
struct Params { const float* in[34]; float* out; unsigned char* ws; };
constexpr size_t MiB = 1ull << 20;
constexpr size_t WL_BYTES = 43 * MiB;
constexpr size_t oWin = 0, oWb = 9175040, oWo = 11272192, oWup = 12320768, oWd = 18087936, oWp = 20971520, oWg = 21233664, oPw = 22282240, oW2 = 22347776, oA2 = 22380544, oG2 = 22413312;
constexpr size_t XB_OFF = 86 * MiB, PB_OFF = 118 * MiB, SS_OFF = 126 * MiB, SAVEA_OFF = 126 * MiB + 256 * 1024, SAVEB_OFF = SAVEA_OFF + 128 * 1024, SAVEU_OFF = SAVEB_OFF + 32 * 1024,
                 C1_OFF = 127 * MiB, C2_OFF = C1_OFF + 512 * 1024, C3_OFF = 128 * MiB, RS_OFF = 129 * MiB, HS_OFF = 130 * MiB, ST_OFF = 132 * MiB;
constexpr size_t BAR_OFF = SS_OFF + 196608;
constexpr int MS = 16384;
struct Bufs {
    bf16_t* W; bf16_t* xb; bf16_t* pb; float* ss0; float* ss1; float* ss2; bf16_t* saveA; bf16_t* saveB; bf16_t* saveU; float* C1; float* C2; float* C3; float* RS; float* HS;
    bf16_t* bufA; bf16_t* bufB; bf16_t* bufC; bf16_t* bufD; float* Wf; bf16_t* KK; bf16_t* V; bf16_t* G; bf16_t* br;
    float* mrg; bf16_t* gates; bf16_t* mb; bf16_t* bufU; bf16_t* act; bf16_t* pp; bf16_t* St; float* DEC;
};
__device__ __forceinline__ Bufs make_bufs(unsigned char* ws, int l) {
    Bufs B; unsigned char* st = ws + ST_OFF;
    B.W = (bf16_t*)(ws + (size_t)l * WL_BYTES); B.xb = (bf16_t*)(ws + XB_OFF); B.pb = (bf16_t*)(ws + PB_OFF);
    B.ss0 = (float*)(ws + SS_OFF); B.ss1 = B.ss0 + MS; B.ss2 = B.ss1 + MS;
    B.saveA = (bf16_t*)(ws + SAVEA_OFF); B.saveB = (bf16_t*)(ws + SAVEB_OFF); B.saveU = (bf16_t*)(ws + SAVEU_OFF);
    B.C1 = (float*)(ws + C1_OFF); B.C2 = (float*)(ws + C2_OFF); B.C3 = (float*)(ws + C3_OFF); B.RS = (float*)(ws + RS_OFF); B.HS = (float*)(ws + HS_OFF);
    B.bufA = (bf16_t*)(st); B.bufB = (bf16_t*)(st + 16 * MiB); B.bufC = (bf16_t*)(st + 72 * MiB); B.bufD = (bf16_t*)(st + 104 * MiB);
    B.Wf = (float*)(st + 152 * MiB); B.KK = (bf16_t*)(st + 184 * MiB)  ; B.V = (bf16_t*)(st + 248 * MiB); B.G = (bf16_t*)(st + 264 * MiB);
    B.br = (bf16_t*)(st + 280 * MiB);
    B.mrg = (float*)(st); B.gates = (bf16_t*)(st + 64 * MiB); B.mb = (bf16_t*)(st + 96 * MiB);
    B.bufU = (bf16_t*)(st); B.act = (bf16_t*)(st + 176 * MiB); B.pp = (bf16_t*)(st + 280 * MiB);
    B.St = (bf16_t*)(st + 344 * MiB); B.DEC = (float*)(st + 376 * MiB);
    return B;
}
constexpr size_t VEC_STRIDE = (size_t)MS * 512;

__device__ __forceinline__ f32x4 mma_tile(const bf16_t* A, int lda, const bf16_t* Bt, int ldb, int K, int lane) {
    f32x4 acc = {0.f, 0.f, 0.f, 0.f};
    const bf16_t* ap = A + (lane & 15) * lda + (lane >> 4) * 8;
    const bf16_t* bp = Bt + (lane & 15) * ldb + (lane >> 4) * 8;
    for (int k = 0; k < K; k += 32) {
        const bf16x8 a = *(const bf16x8*)(ap + k), b = *(const bf16x8*)(bp + k);
        acc = __builtin_amdgcn_mfma_f32_16x16x32_bf16(a, b, acc, 0, 0, 0);
    }
    return acc;
}

template <int NK> __device__ __forceinline__ void load_bfrag(bf16x8 (&f)[NK], const bf16_t* Bt, int ldb, int lane) {
    const bf16_t* bp = Bt + (lane & 15) * ldb + (lane >> 4) * 8;
#pragma unroll
    for (int k = 0; k < NK; ++k) f[k] = *(const bf16x8*)(bp + k * 32);
}
template <int NK> __device__ __forceinline__ f32x4 mma_tile_pre(const bf16_t* A, int lda, const bf16x8 (&f)[NK], int lane) {
    f32x4 acc = {0.f, 0.f, 0.f, 0.f};
    const bf16_t* ap = A + (lane & 15) * lda + (lane >> 4) * 8;
#pragma unroll
    for (int k = 0; k < NK; ++k) acc = __builtin_amdgcn_mfma_f32_16x16x32_bf16(*(const bf16x8*)(ap + k * 32), f[k], acc, 0, 0, 0);
    return acc;
}

template <bool SA, bool SB> __device__ __forceinline__ f32x4 mma_tile64(const bf16_t* A, int ra0, const bf16_t* Bt, int rb0, int lane) {
    f32x4 acc = {0.f, 0.f, 0.f, 0.f};
    const int ra = ra0 + (lane & 15), rb = rb0 + (lane & 15), q = lane >> 4;
    const int sa = SA ? ((ra >> 3) & 7) : 0, sb = SB ? ((rb >> 3) & 7) : 0;
#pragma unroll
    for (int kk = 0; kk < 2; ++kk) {
        const bf16x8 a = *(const bf16x8*)(A + ra * 72 + (((kk * 4 + q) ^ sa) << 3));
        const bf16x8 b = *(const bf16x8*)(Bt + rb * 72 + (((kk * 4 + q) ^ sb) << 3));
        acc = __builtin_amdgcn_mfma_f32_16x16x32_bf16(a, b, acc, 0, 0, 0);
    }
    return acc;
}

__device__ __forceinline__ void tconv(const float* __restrict__ src, bf16_t* __restrict__ dst, int K, int N, const float* __restrict__ scale, float* tile, int& rot) {
    const int tk = K >> 6, tn = N >> 6, nt = tk * tn, G = gridDim.x;
    const int tid = tid_v(), lr = tid >> 4, lc = (tid & 15) * 4;
    const int sn = tid >> 3, sk = (tid & 7) * 8;
    int t = (int)((bid_s() + G - (rot % G)) % G);
    f32x4 v0, v1;
    if (t < nt) { const int kt = t / tn, k0 = kt << 6, n0 = (t - kt * tn) << 6; v0 = *(const f32x4*)(src + (size_t)(k0 + lr) * N + n0 + lc); v1 = *(const f32x4*)(src + (size_t)(k0 + lr + 32) * N + n0 + lc); }
    for (; t < nt; t += G) {
        const int kt = t / tn, k0 = kt << 6, n0 = (t - kt * tn) << 6;
        __syncthreads();
#pragma unroll
        for (int j = 0; j < 4; ++j) { tile[lr * 65 + lc + j] = v0[j]; tile[(lr + 32) * 65 + lc + j] = v1[j]; }
        const int t2 = t + G;
        if (t2 < nt) { const int kt2 = t2 / tn, k2 = kt2 << 6, n2 = (t2 - kt2 * tn) << 6; v0 = *(const f32x4*)(src + (size_t)(k2 + lr) * N + n2 + lc); v1 = *(const f32x4*)(src + (size_t)(k2 + lr + 32) * N + n2 + lc); }
        __syncthreads();
        f32x4 a, bb;
#pragma unroll
        for (int j = 0; j < 4; ++j) { a[j] = tile[(sk + j) * 65 + sn]; bb[j] = tile[(sk + 4 + j) * 65 + sn]; }
        if (scale) { a *= *(const f32x4*)(scale + k0 + sk); bb *= *(const f32x4*)(scale + k0 + sk + 4); }
        *(u32x4*)(dst + (size_t)(n0 + sn) * K + k0 + sk) = pack8(a, bb);
    }
    rot += nt;
}
__device__ __forceinline__ void phase0(unsigned char* shm) {
    float* tile = (float*)shm; int rot = 0;
    for (int l = 0; l < 2; ++l) {
        bf16_t* W = (bf16_t*)(WSP() + (size_t)l * WL_BYTES);
        tconv(IN(3) + (size_t)l * 1024 * 8960, W + oWin, 1024, 8960, IN(2) + l * 1024, tile, rot);
        for (int k = 0; k < 4; ++k) tconv(IN(23) + (size_t)(l * 4 + k) * 512 * 1024, W + oWb + (size_t)k * 1024 * 512, 512, 1024, nullptr, tile, rot);
        tconv(IN(24) + (size_t)l * 1024 * 1024, W + oWo, 1024, 1024, nullptr, tile, rot);
        tconv(IN(26) + (size_t)l * 1024 * 5632, W + oWup, 1024, 5632, IN(25) + l * 1024, tile, rot);
        tconv(IN(29) + (size_t)l * 2816 * 1024, W + oWd, 2816, 1024, nullptr, tile, rot);
        tconv(IN(31) + (size_t)l * 256 * 1024, W + oWp, 256, 1024, nullptr, tile, rot);
        tconv(IN(32) + (size_t)l * 1024 * 1024, W + oWg, 1024, 1024, IN(30) + l * 1024, tile, rot);
        for (int g = 0; g < 4; ++g) tconv(IN(4) + (size_t)(l * 4 + g) * 128 * 128, W + oPw + (size_t)g * 16384, 128, 128, nullptr, tile, rot);
        tconv(IN(8) + (size_t)l * 64 * 512, W + oW2, 64, 512, nullptr, tile, rot);
        tconv(IN(10) + (size_t)l * 64 * 512, W + oA2, 64, 512, nullptr, tile, rot);
        tconv(IN(11) + (size_t)l * 128 * 512, W + oG2, 128, 512, nullptr, tile, rot);
    }
    __syncthreads();
}

__device__ __forceinline__ void phaseX(int l, int s) {
    const Bufs B = make_bufs(WSP(), l);
    const float* xin = l == 0 ? IN(0) : OUTP();
    const float* pin = IN(1) + (size_t)l * 32768 * 256;
    const int lane = tid_v() & 63, gw = bid_s() * 8 + (tid_v() >> 6);
    for (int mb = gw; mb < MS; mb += 4096) {
        f32x4 v[2][4], pv[2]; size_t rg[2];
#pragma unroll
        for (int u = 0; u < 2; ++u) { const int m = mb + 2048 * u; rg[u] = (size_t)((m >> 11) * 4096 + s * 2048 + (m & 2047)); const f32x4* xr = (const f32x4*)(xin + rg[u] * 1024);
#pragma unroll
            for (int i = 0; i < 4; ++i) v[u][i] = xr[lane + 64 * i];
            pv[u] = *(const f32x4*)(pin + rg[u] * 256 + lane * 4); }
#pragma unroll
        for (int u = 0; u < 2; ++u) { const int m = mb + 2048 * u; float sum = 0.f;
#pragma unroll
            for (int i = 0; i < 4; ++i) { const f32x4 x = v[u][i]; sum += x[0] * x[0] + x[1] * x[1] + x[2] * x[2] + x[3] * x[3]; }
            sum = wsum(sum);
            const float rs = rsqrtf(sum * (1.0f / 1024.0f) + 1e-6f);
#pragma unroll
            for (int i = 0; i < 4; ++i) { const f32x4 x = v[u][i] * rs;
                u32x2 w; w.x = cvt_pk_bf16(x[0], x[1]); w.y = cvt_pk_bf16(x[2], x[3]); *(u32x2*)(B.xb + (size_t)m * 1024 + (lane + 64 * i) * 4) = w; }
            if (lane == 0) { B.ss1[m] = 0.f; B.ss2[m] = 0.f; }
            u32x2 w; w.x = cvt_pk_bf16(pv[u][0], pv[u][1]); w.y = cvt_pk_bf16(pv[u][2], pv[u][3]); *(u32x2*)(B.pb + (size_t)m * 256 + lane * 4) = w; }
    }
}

struct PoolRegs { u32x4 rv[3]; };
__device__ __forceinline__ PoolRegs pool_issue(const Bufs& B, int s, int it, int tid) {
    PoolRegs R; const int tt = it >> 2, g = it & 3, m0 = tt * 64, b = m0 >> 11, tl0 = m0 & 2047;
#pragma unroll
    for (int i = 0; i < 3; ++i) {
        int idx = tid + 512 * i; idx = idx < 1280 ? idx : 1279;
        const int r = idx >> 4, c8 = (idx & 15) * 8, tl = tl0 - 16 + r;
        const bf16_t* src = tl >= 0 ? B.bufA + (size_t)(b * 2048 + tl) * 512 + g * 128 + c8 : B.saveA + (size_t)(b * 16 + 16 + tl) * 512 + g * 128 + c8;
        R.rv[i] = *(const u32x4*)src;
        if (tl < 0 && s == 0) R.rv[i] = (u32x4){0u, 0u, 0u, 0u};
    }
    return R;
}
__device__ __forceinline__ void pool_item(const Bufs& B, int l, int s, int it, unsigned char* shm, const PoolRegs& R) {
    const int tid = tid_v(), lane = tid & 63, wid = tid >> 6;
    const int tt = it >> 2, g = it & 3, m0 = tt * 64, b = m0 >> 11, tl0 = m0 & 2047;
    float* raw = (float*)shm;
    bf16_t* dA = (bf16_t*)(shm + 40960);
    bf16x8 pf[4]; load_bfrag<4>(pf, B.W + oPw + (size_t)g * 16384 + wid * 16 * 128, 128, lane);
    __syncthreads();
#pragma unroll
    for (int i = 0; i < 3; ++i) {
        const int idx = tid + 512 * i;
        if (idx < 1280) {
            const int r = idx >> 4, c8 = (idx & 15) * 8, tl = tl0 - 16 + r;
            f32x4 a, bb; unpack8(R.rv[i], a, bb);
            *(f32x4*)(raw + r * 128 + c8) = a; *(f32x4*)(raw + r * 128 + c8 + 4) = bb;
            if (s == 0 && tl >= 2032) *(u32x4*)(B.saveA + (size_t)(b * 16 + tl - 2032) * 512 + g * 128 + c8) = R.rv[i];
        }
    }
    __syncthreads();
    {
        const int win = 2 << g, c = tid & 127, t0 = (tid >> 7) * 16;
        float run = 0.f;
        for (int j = 1; j < win; ++j) run += raw[(16 + t0 - j) * 128 + c];
#pragma unroll 4
        for (int q = 0; q < 16; ++q) {
            const int t = t0 + q, tg = s * 2048 + tl0 + t;
            const float cur = raw[(16 + t) * 128 + c];
            run += cur;
            const int cnt = (tg + 1) < win ? (tg + 1) : win;
            dA[t * 136 + c] = f2bf(run / (float)cnt - cur);
            run -= raw[(16 + t - win + 1) * 128 + c];
        }
    }
    __syncthreads();
    const float* scale = IN(5) + l * 512 + g * 128;
    for (int tile = wid; tile < 32; tile += 8) {
        const int tm = tile >> 3, tn = tile & 7;
        const f32x4 acc = mma_tile_pre<4>(dA + tm * 16 * 136, 136, pf, lane);
        const int col = tn * 16 + (lane & 15);
        const float sc = scale[col];
#pragma unroll
        for (int j = 0; j < 4; ++j) { const int row = tm * 16 + (lane >> 4) * 4 + j; B.br[(size_t)(m0 + row) * 512 + g * 128 + col] = f2bf(acc[j] * sc); }
    }
}

__device__ __forceinline__ void sg_item(const Bufs& B, int l, int s, int it, unsigned char* shm) {
    const int tid = tid_v(), lane = tid & 63, wid = tid >> 6;
    const int ch = it >> 2, g = it & 3, m0 = ch * 128;
    bf16_t* Wm = (bf16_t*)shm;
    bf16_t* VnT = (bf16_t*)(shm + 34816);
    bf16_t* uS = (bf16_t*)(shm + 69632);
    const int t = tid >> 2, part = tid & 3, cl0 = part * 32, cg0 = g * 128 + cl0;
    u32x4 sv[16], vq[4], uv[4]; f32x4 wv[8];
    {
        const u32x4* vp = (const u32x4*)(B.bufC + (size_t)(m0 + t) * 1024 + 512 + part * 128);
#pragma unroll
        for (int i = 0; i < 16; ++i) sv[i] = vp[i];
        const u32x4* vqp = (const u32x4*)(B.bufC + (size_t)(m0 + t) * 1024 + 512 + cg0);
#pragma unroll
        for (int i = 0; i < 4; ++i) vq[i] = vqp[i];
        const float* sw = IN(19) + (size_t)(l * 4 + g) * 16384;
#pragma unroll
        for (int i = 0; i < 8; ++i) wv[i] = *(const f32x4*)(sw + (tid + 512 * i) * 4);
    }
    __syncthreads();
    {
        float sum = 0.f, sq = 0.f;
#pragma unroll
        for (int i = 0; i < 16; ++i) { f32x4 a, bb; unpack8(sv[i], a, bb);
            sum += (a[0] + a[1]) + (a[2] + a[3]) + (bb[0] + bb[1]) + (bb[2] + bb[3]);
            sq += a[0] * a[0] + a[1] * a[1] + a[2] * a[2] + a[3] * a[3] + bb[0] * bb[0] + bb[1] * bb[1] + bb[2] * bb[2] + bb[3] * bb[3]; }
        sum += __shfl_xor(sum, 1); sum += __shfl_xor(sum, 2); sq += __shfl_xor(sq, 1); sq += __shfl_xor(sq, 2);
        const float mean = sum * (1.0f / 512.0f), var = sq * (1.0f / 512.0f) - mean * mean, rstd = rsqrtf(fmaxf(var, 0.f) + 1e-5f);
#pragma unroll
        for (int i = 0; i < 4; ++i) { const int idx = tid + 512 * i; uv[i] = *(const u32x4*)(B.bufC + (size_t)(m0 + (idx >> 4)) * 1024 + g * 128 + (idx & 15) * 8); }
        const float* lnw = IN(17) + l * 512 + cg0; const float* lnb = IN(18) + l * 512 + cg0;
#pragma unroll
        for (int i = 0; i < 4; ++i) { f32x4 a, bb; unpack8(vq[i], a, bb);
#pragma unroll
            for (int j = 0; j < 4; ++j) {
                VnT[(cl0 + i * 8 + j) * 136 + t] = f2bf((a[j] - mean) * rstd * lnw[i * 8 + j] + lnb[i * 8 + j]);
                VnT[(cl0 + i * 8 + 4 + j) * 136 + t] = f2bf((bb[j] - mean) * rstd * lnw[i * 8 + 4 + j] + lnb[i * 8 + 4 + j]); } }
#pragma unroll
        for (int i = 0; i < 8; ++i) { const int idx = tid + 512 * i, tt = idx >> 5, s4 = (idx & 31) * 4;
            u32x2 w; w.x = cvt_pk_bf16(s4 <= tt ? wv[i][0] : 0.f, s4 + 1 <= tt ? wv[i][1] : 0.f); w.y = cvt_pk_bf16(s4 + 2 <= tt ? wv[i][2] : 0.f, s4 + 3 <= tt ? wv[i][3] : 0.f);
            *(u32x2*)(Wm + tt * 136 + s4) = w; }
#pragma unroll
        for (int i = 0; i < 4; ++i) { const int idx = tid + 512 * i; *(u32x4*)(uS + (idx >> 4) * 136 + (idx & 15) * 8) = uv[i]; }
    }
    __syncthreads();
    const float* sb = IN(20) + (l * 4 + g) * 128;
    for (int tile = wid; tile < 64; tile += 8) {
        const int tm = tile >> 3, tn = tile & 7;
        const int Kc = ((tm * 16 + 16 + 31) >> 5) << 5;
        const f32x4 acc = mma_tile(Wm + tm * 16 * 136, 136, VnT + tn * 16 * 136, 136, Kc, lane);
        const int c = tn * 16 + (lane & 15);
#pragma unroll
        for (int j = 0; j < 4; ++j) { const int tq = tm * 16 + (lane >> 4) * 4 + j;
            B.br[2 * VEC_STRIDE + (size_t)(m0 + tq) * 512 + g * 128 + c] = f2bf(bf2f(uS[tq * 136 + c]) * (acc[j] + sb[tq])); }
    }
}

__device__ __forceinline__ float rsum8(float v) { v += dppf<0xB1>(v); v += dppf<0x4E>(v); v += dppf<0x141>(v); return v; }
struct PrepRegs { u32x4 cw, pw; };
__device__ __forceinline__ PrepRegs prep_issue(const Bufs& B, int s, int it, int tid) {
    PrepRegs R; const int m0 = it * 16, b = m0 >> 11, tl0 = m0 & 2047;
    const bf16_t* sB = B.saveB + b * 1792; const u32x4 zero4 = {0u, 0u, 0u, 0u};
    { const int t = tid >> 5, cg = tid & 31, c0 = 1536 + cg * 8, m = m0 + t, tl = tl0 + t;
      R.cw = *(const u32x4*)(B.bufB + (size_t)m * 1792 + c0);
      R.pw = tl > 0 ? *(const u32x4*)(B.bufB + (size_t)(m - 1) * 1792 + c0) : (s == 1 ? *(const u32x4*)(sB + c0) : zero4); }
    return R;
}
__device__ __forceinline__ void prep_item(const Bufs& B, int l, int s, int it, unsigned char* shm, const bf16x8 (&w2f)[4][2], const bf16x8 (&a2f)[4][2], const PrepRegs& R) {
    const int tid = tid_v(), lane = tid & 63, wid = tid >> 6;
    const int m0 = it * 16, b = m0 >> 11, tl0 = m0 & 2047;
    bf16_t* Lw = (bf16_t*)shm;
    bf16_t* La = (bf16_t*)(shm + 2304);
    bf16_t* Lg = (bf16_t*)(shm + 4608);
    float* Aa = (float*)(shm + 9216);
    float* Dd = (float*)(shm + 9216 + 32768);
    const float* mu = IN(6) + l * 1792;
    const bf16_t* sB = B.saveB + b * 1792;
    const u32x4 zero4 = {0u, 0u, 0u, 0u};
    u32x4 c3w[2][3], p3w[2][3];
#pragma unroll
    for (int tt = 0; tt < 2; ++tt) { const int t = wid + 8 * tt, m = m0 + t, tl = tl0 + t; const bf16_t* cr = B.bufB + (size_t)m * 1792 + lane * 8;
#pragma unroll
        for (int q = 0; q < 3; ++q) { c3w[tt][q] = *(const u32x4*)(cr + q * 512); p3w[tt][q] = tl > 0 ? *(const u32x4*)(cr - 1792 + q * 512) : (s == 1 ? *(const u32x4*)(sB + q * 512 + lane * 8) : zero4); } }
    __syncthreads();
    {
        const int t = tid >> 5, cg = tid & 31, c0 = 1536 + cg * 8;
        f32x4 c0v, c1v, p0v, p1v; unpack8(R.cw, c0v, c1v); unpack8(R.pw, p0v, p1v);
        const f32x4 m0v = *(const f32x4*)(mu + c0), m1v = *(const f32x4*)(mu + c0 + 4);
        f32x4 x0 = c0v + m0v * (p0v - c0v), x1 = c1v + m1v * (p1v - c1v);
        if (cg < 8) {
#pragma unroll
            for (int j = 0; j < 4; ++j) { x0[j] = 2.0f * sigm(2.0f * x0[j]) - 1.0f; x1[j] = 2.0f * sigm(2.0f * x1[j]) - 1.0f; }
            *(u32x4*)(Lw + t * 72 + cg * 8) = pack8(x0, x1);
        } else if (cg < 16) {
            *(u32x4*)(La + t * 72 + (cg - 8) * 8) = pack8(x0, x1);
        } else {
#pragma unroll
            for (int j = 0; j < 4; ++j) { x0[j] = sigm(x0[j]); x1[j] = sigm(x1[j]); }
            *(u32x4*)(Lg + t * 136 + (cg - 16) * 8) = pack8(x0, x1);
        }
    }
    __syncthreads();
    {
        const float* w0 = IN(7) + l * 512; const float* a0 = IN(9) + l * 512;
#pragma unroll
        for (int i = 0; i < 4; ++i) {
            const int tn = wid + 8 * i, c = tn * 16 + (lane & 15);
            bf16x8 g2f[4]; load_bfrag<4>(g2f, B.W + oG2 + tn * 16 * 128, 128, lane);
            f32x4 acc = mma_tile_pre<2>(Lw, 72, w2f[i], lane);
#pragma unroll
            for (int j = 0; j < 4; ++j) { const int t = (lane >> 4) * 4 + j; Dd[t * 512 + c] = __expf(-0.6065306597f * sigm(w0[c] + acc[j])); }
            acc = mma_tile_pre<2>(La, 72, a2f[i], lane);
#pragma unroll
            for (int j = 0; j < 4; ++j) { const int t = (lane >> 4) * 4 + j; Aa[t * 512 + c] = sigm(a0[c] + acc[j]); }
            acc = mma_tile_pre<4>(Lg, 136, g2f, lane);
#pragma unroll
            for (int j = 0; j < 4; ++j) { const int t = (lane >> 4) * 4 + j; B.G[(size_t)(m0 + t) * 512 + c] = f2bf(acc[j]); }
        }
    }
    __syncthreads();
    const float* kkp = IN(12) + l * 512; const float* kap = IN(13) + l * 512; const float* rkp = IN(14) + l * 512;
    const int c0 = lane * 8, h = lane >> 3;
#pragma unroll
    for (int tt = 0; tt < 2; ++tt) {
        const int t = wid + 8 * tt, m = m0 + t, tl = tl0 + t;
        const bf16_t* cr = B.bufB + (size_t)m * 1792;
        f32x4 r[2], k[2], v[2];
#pragma unroll
        for (int q = 0; q < 3; ++q) {
            f32x4 c0v, c1v, p0v, p1v; unpack8(c3w[tt][q], c0v, c1v); unpack8(p3w[tt][q], p0v, p1v);
            const f32x4 m0v = *(const f32x4*)(mu + q * 512 + c0), m1v = *(const f32x4*)(mu + q * 512 + c0 + 4);
            const f32x4 x0 = c0v + m0v * (p0v - c0v), x1 = c1v + m1v * (p1v - c1v);
            if (q == 0) { r[0] = x0; r[1] = x1; } else if (q == 1) { k[0] = x0; k[1] = x1; } else { v[0] = x0; v[1] = x1; }
        }
        f32x4 kk[2], kp[2], ka[2], wv[2], av[2];
        float n2 = 0.f, c2 = 0.f, c3 = 0.f;
#pragma unroll
        for (int e = 0; e < 2; ++e) {
            av[e] = *(const f32x4*)(Aa + t * 512 + c0 + 4 * e); wv[e] = *(const f32x4*)(Dd + t * 512 + c0 + 4 * e);
            const f32x4 kkw = *(const f32x4*)(kkp + c0 + 4 * e), kaw = *(const f32x4*)(kap + c0 + 4 * e), rkw = *(const f32x4*)(rkp + c0 + 4 * e);
            kk[e] = k[e] * kkw;
            kp[e] = k[e] * (1.0f + (av[e] - 1.0f) * kaw);
#pragma unroll
            for (int j = 0; j < 4; ++j) { n2 += kk[e][j] * kk[e][j]; c2 += kp[e][j] * r[e][j]; c3 += r[e][j] * kp[e][j] * rkw[j]; }
        }
        n2 = rsum8(n2); c2 = rsum8(c2); c3 = rsum8(c3);
        const float inv = 1.0f / fmaxf(sqrtf(n2), 1e-12f);
        float c1 = 0.f;
#pragma unroll
        for (int e = 0; e < 2; ++e) { kk[e] = kk[e] * inv; ka[e] = kk[e] * av[e];
#pragma unroll
            for (int j = 0; j < 4; ++j) c1 += ka[e][j] * r[e][j]; }
        c1 = rsum8(c1);
        const size_t o = (size_t)m * 512 + c0;
        *(f32x4*)(B.Wf + o) = wv[0]; *(f32x4*)(B.Wf + o + 4) = wv[1];
        *(u32x4*)(B.KK + o) = pack8(kk[0], kk[1]);
        *(u32x4*)(B.KK + VEC_STRIDE + o) = pack8(wv[0] * r[0], wv[1] * r[1]);
        *(u32x4*)(B.KK + 2 * VEC_STRIDE + o) = pack8(ka[0], ka[1]);
        *(u32x4*)(B.KK + 3 * VEC_STRIDE + o) = pack8(kp[0], kp[1]);
        *(u32x4*)(B.V + o) = pack8(v[0], v[1]);
        if ((lane & 7) == 0) { B.C1[m * 8 + h] = c1; B.C2[m * 8 + h] = c2; B.C3[m * 8 + h] = c3; }
    }
    if (s == 0 && tl0 + 16 == 2048) for (int c = tid; c < 1792; c += 512) B.saveB[b * 1792 + c] = B.bufB[(size_t)(b * 2048 + 2047) * 1792 + c];
}

__device__ __forceinline__ void hg_cum(const u32x4 (&ev)[2], int l, int h, const float* hlb, float* cumS, float* lbS, int tid) {
    __syncthreads();
    if (tid < 128) lbS[tid] = l == 0 ? 1.0f : 1.0f - sigm(hlb[512 + h * 128 + tid] - hlb[h * 128 + tid]);
    __syncthreads();
#pragma unroll
    for (int q = 0; q < 2; ++q) {
        const int idx = tid + 512 * q, t = idx >> 4, k8 = (idx & 15) * 8;
        f32x4 a, bb; unpack8(ev[q], a, bb);
        const f32x4 l0 = *(const f32x4*)(lbS + k8), l1 = *(const f32x4*)(lbS + k8 + 4);
#pragma unroll
        for (int j = 0; j < 4; ++j) { a[j] = __logf(fmaxf(1.0f - l0[j] * a[j], 1e-30f)); bb[j] = __logf(fmaxf(1.0f - l1[j] * bb[j], 1e-30f)); }
        *(f32x4*)(cumS + t * 128 + k8) = a; *(f32x4*)(cumS + t * 128 + k8 + 4) = bb;
    }
    __syncthreads();
    const int k = tid & 127, seg = tid >> 7;
    { float run = 0.f;
#pragma unroll
      for (int tt = 0; tt < 16; ++tt) { const int t = seg * 16 + tt; run += cumS[t * 128 + k]; cumS[t * 128 + k] = run; } }
    __syncthreads();
    float off = 0.f;
    for (int sp = 0; sp < seg; ++sp) off += cumS[(16 * sp + 15) * 128 + k];
    __syncthreads();
#pragma unroll
    for (int tt = 0; tt < 16; ++tt) cumS[(seg * 16 + tt) * 128 + k] += off;
    __syncthreads();
}

struct HgRegs { u32x4 ev[2], iv[2]; };
__device__ __forceinline__ HgRegs hgA_issue(const Bufs& B, int it, int tid) {
    HgRegs R; const int bh = it >> 5, ch = it & 31, b = bh >> 2, h = bh & 3, m0 = b * 2048 + ch * 64;
#pragma unroll
    for (int q = 0; q < 2; ++q) { const int idx = tid + 512 * q; const bf16_t* rowp = B.bufD + (size_t)(m0 + (idx >> 4)) * 1536 + h * 128 + (idx & 15) * 8; R.ev[q] = *(const u32x4*)(rowp + 512); R.iv[q] = *(const u32x4*)(rowp + 1024); }
    return R;
}
__device__ __forceinline__ void hgA_item(const Bufs& B, int l, int it, unsigned char* shm, const float* hlb, const HgRegs& R) {
    const int tid = tid_v(), lane = tid & 63, wid = tid >> 6;
    const int bh = it >> 5, ch = it & 31, b = bh >> 2, h = bh & 3, m0 = b * 2048 + ch * 64;
    float* cumS = (float*)shm;
    bf16_t* kdT = (bf16_t*)(shm + 32768);
    bf16_t* iT = (bf16_t*)(shm + 32768 + 18432);
    float* lbS = (float*)(shm + 32768 + 36864);
    hg_cum(R.ev, l, h, hlb, cumS, lbS, tid);
#pragma unroll
    for (int q = 0; q < 2; ++q) {
        const int idx = tid + 512 * q, t = idx >> 4, k8 = (idx & 15) * 8;
        f32x4 a, bb; unpack8(R.ev[q], a, bb);
        const u32x4 iw = R.iv[q];
        const int tx = t ^ (((k8 >> 3) & 7) << 3);
#pragma unroll
        for (int j = 0; j < 4; ++j) {
            kdT[(k8 + j) * 72 + tx] = f2bf(lbS[k8 + j] * a[j] * __expf(cumS[63 * 128 + k8 + j] - cumS[t * 128 + k8 + j]));
            kdT[(k8 + 4 + j) * 72 + tx] = f2bf(lbS[k8 + 4 + j] * bb[j] * __expf(cumS[63 * 128 + k8 + 4 + j] - cumS[t * 128 + k8 + 4 + j]));
        }
        iT[(k8 + 0) * 72 + tx] = (bf16_t)(iw.x & 0xffffu); iT[(k8 + 1) * 72 + tx] = (bf16_t)(iw.x >> 16); iT[(k8 + 2) * 72 + tx] = (bf16_t)(iw.y & 0xffffu); iT[(k8 + 3) * 72 + tx] = (bf16_t)(iw.y >> 16);
        iT[(k8 + 4) * 72 + tx] = (bf16_t)(iw.z & 0xffffu); iT[(k8 + 5) * 72 + tx] = (bf16_t)(iw.z >> 16); iT[(k8 + 6) * 72 + tx] = (bf16_t)(iw.w & 0xffffu); iT[(k8 + 7) * 72 + tx] = (bf16_t)(iw.w >> 16);
    }
    if (tid < 128) B.DEC[it * 128 + tid] = __expf(cumS[63 * 128 + tid]);
    __syncthreads();
    bf16_t* Sg = B.St + (size_t)it * 16384;
    for (int tile = wid; tile < 64; tile += 8) {
        const int tm = tile >> 3, tn = tile & 7;
        const f32x4 acc = mma_tile64<true, true>(iT, tm * 16, kdT, tn * 16, lane);
#pragma unroll
        for (int j = 0; j < 4; ++j) Sg[(tm * 16 + (lane >> 4) * 4 + j) * 128 + tn * 16 + (lane & 15)] = f2bf(acc[j]);
    }
}

__device__ __forceinline__ void hgC_item(const Bufs& B, int l, int it, unsigned char* shm, const float* hlb, const float* hn) {
    const int tid = tid_v(), lane = tid & 63, wid = tid >> 6;
    const int bh = it >> 5, ch = it & 31, b = bh >> 2, h = bh & 3, m0 = b * 2048 + ch * 64;
    float* cumS = (float*)shm;
    bf16_t* qe = (bf16_t*)(shm + 33792);
    bf16_t* qa = (bf16_t*)(shm + 51200);
    bf16_t* kb = (bf16_t*)(shm + 68608);
    bf16_t* iT = (bf16_t*)(shm + 86016);
    bf16_t* P = (bf16_t*)(shm + 104448);
    float* lbS = (float*)(shm + 113664);
    bf16x8 sf[4]; load_bfrag<4>(sf, B.St + (size_t)it * 16384 + wid * 16 * 128, 128, lane);
    u32x4 ev[2], iv[2], qv[2];
#pragma unroll
    for (int q = 0; q < 2; ++q) { const int idx = tid + 512 * q; const bf16_t* rowp = B.bufD + (size_t)(m0 + (idx >> 4)) * 1536 + h * 128 + (idx & 15) * 8; qv[q] = *(const u32x4*)rowp; ev[q] = *(const u32x4*)(rowp + 512); iv[q] = *(const u32x4*)(rowp + 1024); }
    hg_cum(ev, l, h, hlb, cumS, lbS, tid);
#pragma unroll
    for (int q = 0; q < 2; ++q) {
        const int idx = tid + 512 * q, t = idx >> 4, k8 = (idx & 15) * 8;
        f32x4 q0, q1, e0, e1; unpack8(qv[q], q0, q1); unpack8(ev[q], e0, e1);
        const u32x4 iw = iv[q];
        const int tx = t ^ (((k8 >> 3) & 7) << 3);
        const f32x4 c0 = *(const f32x4*)(cumS + t * 128 + k8), c1 = *(const f32x4*)(cumS + t * 128 + k8 + 4), m0v = *(const f32x4*)(cumS + 31 * 128 + k8), m1v = *(const f32x4*)(cumS + 31 * 128 + k8 + 4);
        const f32x4 l0 = *(const f32x4*)(lbS + k8), l1 = *(const f32x4*)(lbS + k8 + 4);
        f32x4 x0, x1, y0, y1, z0, z1;
#pragma unroll
        for (int j = 0; j < 4; ++j) {
            x0[j] = q0[j] * __expf(c0[j]); x1[j] = q1[j] * __expf(c1[j]);
            y0[j] = q0[j] * __expf(fminf(c0[j] - m0v[j], 80.f)); y1[j] = q1[j] * __expf(fminf(c1[j] - m1v[j], 80.f));
            z0[j] = l0[j] * e0[j] * __expf(fminf(m0v[j] - c0[j], 80.f)); z1[j] = l1[j] * e1[j] * __expf(fminf(m1v[j] - c1[j], 80.f));
        }
        *(u32x4*)(qe + t * 136 + k8) = pack8(x0, x1); *(u32x4*)(qa + t * 136 + k8) = pack8(y0, y1); *(u32x4*)(kb + t * 136 + k8) = pack8(z0, z1);
        iT[(k8 + 0) * 72 + tx] = (bf16_t)(iw.x & 0xffffu); iT[(k8 + 1) * 72 + tx] = (bf16_t)(iw.x >> 16); iT[(k8 + 2) * 72 + tx] = (bf16_t)(iw.y & 0xffffu); iT[(k8 + 3) * 72 + tx] = (bf16_t)(iw.y >> 16);
        iT[(k8 + 4) * 72 + tx] = (bf16_t)(iw.z & 0xffffu); iT[(k8 + 5) * 72 + tx] = (bf16_t)(iw.z >> 16); iT[(k8 + 6) * 72 + tx] = (bf16_t)(iw.w & 0xffffu); iT[(k8 + 7) * 72 + tx] = (bf16_t)(iw.w >> 16);
    }
    __syncthreads();
    for (int tile = wid; tile < 16; tile += 8) {
        const int tm = tile >> 2, tn = tile & 3;
        f32x4 acc = {0.f, 0.f, 0.f, 0.f};
        if (tn <= tm) acc = mma_tile(qa + tm * 16 * 136, 136, kb + tn * 16 * 136, 136, 128, lane);
        const int sc = tn * 16 + (lane & 15);
#pragma unroll
        for (int j = 0; j < 4; ++j) { const int t = tm * 16 + (lane >> 4) * 4 + j; P[t * 72 + sc] = f2bf(sc <= t ? acc[j] : 0.f); }
    }
    __syncthreads();
    float* oS = cumS;
    for (int tile = wid; tile < 32; tile += 8) {
        const int tm = tile >> 3, tn = tile & 7;
        const f32x4 acc = mma_tile_pre<4>(qe + tm * 16 * 136, 136, sf, lane) + mma_tile64<false, true>(P, tm * 16, iT, tn * 16, lane);
#pragma unroll
        for (int j = 0; j < 4; ++j) oS[(tm * 16 + (lane >> 4) * 4 + j) * 132 + tn * 16 + (lane & 15)] = acc[j];
    }
    __syncthreads();
#pragma unroll
    for (int q = 0; q < 2; ++q) {
        const int idx = tid + 512 * q, t = idx >> 4, v8 = (idx & 15) * 8;
        f32x4 o0 = *(const f32x4*)(oS + t * 132 + v8), o1 = *(const f32x4*)(oS + t * 132 + v8 + 4);
        float ssq = o0[0] * o0[0] + o0[1] * o0[1] + o0[2] * o0[2] + o0[3] * o0[3] + o1[0] * o1[0] + o1[1] * o1[1] + o1[2] * o1[2] + o1[3] * o1[3];
        ssq = rsum16(ssq);
        const float rs = rsqrtf(ssq * (1.0f / 128.0f) + 1e-6f);
        const f32x4 n0 = *(const f32x4*)(hn + h * 128 + v8), n1 = *(const f32x4*)(hn + h * 128 + v8 + 4);
        *(u32x4*)(B.br + 3 * VEC_STRIDE + (size_t)(m0 + t) * 512 + h * 128 + v8) = pack8(o0 * rs * n0, o1 * rs * n1);
    }
}

__device__ __forceinline__ void phase2(int l, int s, unsigned char* shm) {
    const Bufs B = make_bufs(WSP(), l);
    const float* hlb = IN(21);
    {
        const int lane = tid_v() & 63, wid = tid_v() >> 6;
        bf16x8 w2f[4][2], a2f[4][2];
#pragma unroll
        for (int i = 0; i < 4; ++i) { const int tn = wid + 8 * i; load_bfrag<2>(w2f[i], B.W + oW2 + tn * 16 * 64, 64, lane); load_bfrag<2>(a2f[i], B.W + oA2 + tn * 16 * 64, 64, lane); }
        const int tid = tid_v(), G = (int)gridDim.x; int it = bid_s();
        PrepRegs R = prep_issue(B, s, it, tid);
        for (; it < 1024; it += G) { const PrepRegs N = prep_issue(B, s, it + G < 1024 ? it + G : it, tid); prep_item(B, l, s, it, shm, w2f, a2f, R); R = N; }
    }
    {
        const int tid = tid_v(), G = (int)gridDim.x; int it = bid_s();
        HgRegs R = hgA_issue(B, it, tid);
        for (; it < 1024; it += G) { const HgRegs N = hgA_issue(B, it + G < 1024 ? it + G : it, tid); hgA_item(B, l, it, shm, hlb, R); R = N; }
    }
    for (int it = bid_s(); it < 512; it += gridDim.x) sg_item(B, l, s, it, shm);
    {
        const int tid = tid_v(), G = (int)gridDim.x; int it = bid_s();
        PoolRegs R = pool_issue(B, s, it, tid);
        for (; it < 1024; it += G) { const PoolRegs N = pool_issue(B, s, it + G < 1024 ? it + G : it, tid); pool_item(B, l, s, it, shm, R); R = N; }
    }
}
__device__ __forceinline__ void scans(int l, int s, unsigned char* shm) {
    const Bufs B = make_bufs(WSP(), l);
    constexpr int CS = 16, NCH = 2048 / CS, RST = 340;
    const int tid = tid_v(), lane = tid & 63, wid = tid >> 6;
    const int c = bid_s(), xcd = c & 7, jj = c >> 3;
    const int bhr = xcd * 8 + (jj >> 2), b_r = bhr >> 3, h_r = bhr & 7, rbase = (jj & 3) * 16;
    float* rbuf = (float*)shm;
    float* yl = (float*)(shm + 2 * CS * RST * 4);
    bf16_t* Y = B.br + VEC_STRIDE;
    __syncthreads();
    if (wid < 4) {
        const int loc = wid * 4 + (lane >> 4), col4 = (lane & 15) * 4;
        float* RSp = B.RS + ((size_t)bhr * 64 + rbase + loc) * 64 + col4;
        f32x2 S0 = {0.f, 0.f}, S1 = {0.f, 0.f};
        if (s == 1) { const f32x4 t = *(const f32x4*)RSp; S0 = t.xy; S1 = t.zw; }
        asm volatile("" : "+v"(S0), "+v"(S1));
        __syncthreads();
#pragma unroll 1
        for (int cidx = 0; cidx < NCH; ++cidx) {
            if (cidx > 0) { const int st = tid >> 4, r = tid & 15; Y[(size_t)(b_r * 2048 + (cidx - 1) * CS + st) * 512 + h_r * 64 + rbase + r] = f2bf(yl[((cidx - 1) & 1) * (CS * 16) + tid]); }
            const float* bp = rbuf + (cidx & 1) * (CS * RST); float* ylw = yl + (cidx & 1) * (CS * 16);
            const unsigned ab = (unsigned)(size_t)(PG8_LAS const float*)bp;
            const unsigned a_col = ab + col4 * 4, a_row = ab + 1280 + loc * 4, a_cc = ab + 1344;
            f32x4 Aw4, Akk4, Awr4, Aka4, Akp4, Bw4, Bkk4, Bwr4, Bka4, Bkp4; float Av, Bv; f32x2 Acc, Bcc;
            float ykeep = 0.f;
#define RW_LOAD(P, ST) do { \
                asm volatile("ds_read_b128 %0, %1 offset:%2" : "=v"(P##w4) : "v"(a_col), "n"((ST) * 1360)); \
                asm volatile("ds_read_b128 %0, %1 offset:%2" : "=v"(P##kk4) : "v"(a_col), "n"((ST) * 1360 + 256)); \
                asm volatile("ds_read_b128 %0, %1 offset:%2" : "=v"(P##wr4) : "v"(a_col), "n"((ST) * 1360 + 512)); \
                asm volatile("ds_read_b128 %0, %1 offset:%2" : "=v"(P##ka4) : "v"(a_col), "n"((ST) * 1360 + 768)); \
                asm volatile("ds_read_b128 %0, %1 offset:%2" : "=v"(P##kp4) : "v"(a_col), "n"((ST) * 1360 + 1024)); \
                asm volatile("ds_read_b32 %0, %1 offset:%2" : "=v"(P##v) : "v"(a_row), "n"((ST) * 1360)); \
                asm volatile("ds_read_b64 %0, %1 offset:%2" : "=v"(P##cc) : "v"(a_cc), "n"((ST) * 1360)); } while (0)
#define RW_WAIT(P, N) asm volatile("s_waitcnt lgkmcnt(" #N ")" : "+v"(P##w4), "+v"(P##kk4), "+v"(P##wr4), "+v"(P##ka4), "+v"(P##kp4), "+v"(P##v), "+v"(P##cc))
#define RW_STEP(P, ST) do { \
                f32x2 t = S0 * P##kk4.xy; t = S1 * P##kk4.zw + t; \
                f32x2 u = S0 * P##wr4.xy; u = S1 * P##wr4.zw + u; \
                const f32x2 vv = {P##v, P##v}; \
                const f32x2 Ta = S0 * P##w4.xy + vv * P##kp4.xy, Tb = S1 * P##w4.zw + vv * P##kp4.zw; \
                float pd = t.x + t.y, yq = u.x + u.y; \
                pd = rsum16(pd); yq = rsum16(yq); \
                const float sa = -pd; const f32x2 sa2 = {sa, sa}; \
                S0 = Ta + sa2 * P##ka4.xy; S1 = Tb + sa2 * P##ka4.zw; \
                const float y = yq + sa * P##cc.x + P##v * P##cc.y; \
                ykeep = (lane & 15) == (ST) ? y : ykeep; } while (0)
#define RW_PAIR(ST) do { RW_LOAD(B, (ST) + 1); RW_WAIT(A, 7); RW_STEP(A, ST); RW_LOAD(A, (ST) + 2); RW_WAIT(B, 7); RW_STEP(B, (ST) + 1); } while (0)
            RW_LOAD(A, 0);
            RW_PAIR(0); RW_PAIR(2); RW_PAIR(4); RW_PAIR(6); RW_PAIR(8); RW_PAIR(10); RW_PAIR(12);
            RW_LOAD(B, 15); RW_WAIT(A, 7); RW_STEP(A, 14); RW_WAIT(B, 0); RW_STEP(B, 15);
#undef RW_PAIR
#undef RW_STEP
#undef RW_WAIT
#undef RW_LOAD
            ylw[(lane & 15) * 16 + loc] = ykeep;
            __syncthreads();
        }
        { const int st = tid >> 4, r = tid & 15; Y[(size_t)(b_r * 2048 + (NCH - 1) * CS + st) * 512 + h_r * 64 + rbase + r] = f2bf(yl[((NCH - 1) & 1) * (CS * 16) + tid]); }
        { f32x4 t; t.xy = S0; t.zw = S1; *(f32x4*)RSp = t; }
    } else {
        const int lt = tid - 256;
        const unsigned char* src[4]; unsigned inc[4]; int dsto[4]; bool isf[4], act[4];
#pragma unroll
        for (int i = 0; i < 4; ++i) {
            int idx = lt + 256 * i; act[i] = idx < CS * 50; idx = act[i] ? idx : CS * 50 - 1;
            const int st = idx / 50, k = idx - st * 50;
            const size_t m = (size_t)(b_r * 2048 + st) * 512 + h_r * 64;
            if (k < 16) { src[i] = (const unsigned char*)(B.Wf + m + k * 4); inc[i] = CS * 512 * 4; dsto[i] = st * RST + k * 4; isf[i] = true; }
            else if (k < 48) { src[i] = (const unsigned char*)(B.KK + (size_t)((k - 16) >> 3) * VEC_STRIDE + m + ((k - 16) & 7) * 8); inc[i] = CS * 512 * 2; dsto[i] = st * RST + 64 * (1 + ((k - 16) >> 3)) + ((k - 16) & 7) * 8; isf[i] = false; }
            else { src[i] = (const unsigned char*)(B.V + m + rbase + (k - 48) * 8); inc[i] = CS * 512 * 2; dsto[i] = st * RST + 320 + (k - 48) * 8; isf[i] = false; }
        }
        const float* c1p = B.C1 + (size_t)(b_r * 2048 + (lt & (CS - 1))) * 8 + h_r; const float* c2p = B.C2 + (size_t)(b_r * 2048 + (lt & (CS - 1))) * 8 + h_r;
        const int e = c * 256 + lt, bhh = e >> 11, hv = (e >> 4) & 127, hk8 = (e & 15) * 8;
        float* HSp = B.HS + ((size_t)bhh * 128 + hv) * 128 + hk8;
        f32x4 h0 = {0.f, 0.f, 0.f, 0.f}, h1 = {0.f, 0.f, 0.f, 0.f};
        if (s == 1) { h0 = *(const f32x4*)HSp; h1 = *(const f32x4*)(HSp + 4); }
        asm volatile("" : "+v"(h0), "+v"(h1));
        u32x4 rrA[4], rrB[4]; float s1A, s2A, s1B, s2B;
        u32x4 Lw = *(const u32x4*)(B.St + ((size_t)(bhh * 32) * 128 + hv) * 128 + hk8);
        f32x4 d0 = *(const f32x4*)(B.DEC + (bhh * 32) * 128 + hk8), d1 = *(const f32x4*)(B.DEC + (bhh * 32) * 128 + hk8 + 4);
#define LD_ISSUE(rr, sc1, sc2) do { _Pragma("unroll") for (int i = 0; i < 4; ++i) { rr[i] = *(const u32x4*)src[i]; src[i] += inc[i]; } sc1 = *c1p; sc2 = *c2p; c1p += CS * 8; c2p += CS * 8; } while (0)
#define LD_STORE(rr, sc1, sc2, par) do { float* rb = rbuf + (par) * (CS * RST); \
            _Pragma("unroll") for (int i = 0; i < 4; ++i) { if (act[i]) { float* dst = rb + dsto[i]; \
                if (isf[i]) { *(u32x4*)dst = rr[i]; } else { f32x4 a, bb; unpack8(rr[i], a, bb); *(f32x4*)dst = a; *(f32x4*)(dst + 4) = bb; } } } \
            if (lt < CS) { rb[lt * RST + 336] = sc1; rb[lt * RST + 337] = sc2; } } while (0)
        LD_ISSUE(rrA, s1A, s2A); LD_STORE(rrA, s1A, s2A, 0); LD_ISSUE(rrA, s1A, s2A);
        __syncthreads();
#pragma unroll 1
        for (int cidx = 0; cidx < NCH; cidx += 4) {
            LD_ISSUE(rrB, s1B, s2B);
            {
                bf16_t* sp = B.St + ((size_t)(bhh * 32 + (cidx >> 2)) * 128 + hv) * 128 + hk8;
                *(u32x4*)sp = pack8(h0, h1);
                f32x4 l0, l1; unpack8(Lw, l0, l1);
                h0 = d0 * h0 + l0; h1 = d1 * h1 + l1;
            }
            LD_STORE(rrA, s1A, s2A, 1);
            __syncthreads();
            LD_ISSUE(rrA, s1A, s2A);
            LD_STORE(rrB, s1B, s2B, 0);
            __syncthreads();
            LD_ISSUE(rrB, s1B, s2B);
            {   const int pn = (cidx >> 2) + 1, item = bhh * 32 + (pn < 32 ? pn : 31);
                Lw = *(const u32x4*)(B.St + ((size_t)item * 128 + hv) * 128 + hk8);
                d0 = *(const f32x4*)(B.DEC + item * 128 + hk8); d1 = *(const f32x4*)(B.DEC + item * 128 + hk8 + 4); }
            LD_STORE(rrA, s1A, s2A, 1);
            __syncthreads();
            LD_ISSUE(rrA, s1A, s2A);
            LD_STORE(rrB, s1B, s2B, 0);
            __syncthreads();
        }
        *(f32x4*)HSp = h0; *(f32x4*)(HSp + 4) = h1;
#undef LD_ISSUE
#undef LD_STORE
    }
}

__device__ __forceinline__ void phase4(int l, unsigned char* shm) {
    const Bufs B = make_bufs(WSP(), l);
    const int lane = tid_v() & 63, gw = bid_s() * 8 + (tid_v() >> 6);
    const float* lnw = IN(15) + l * 512; const float* lnb = IN(16) + l * 512; const float* hn = IN(22) + l * 512;
    bf16_t* Y = B.br + VEC_STRIDE;
    for (int mb = gw; mb < MS; mb += 4096) {
        const int c0 = lane * 8, h = lane >> 3;
        u32x4 yw[2], gwd[2], vwd[2]; float c3v[2];
#pragma unroll
        for (int u = 0; u < 2; ++u) { const size_t o = (size_t)(mb + 2048 * u) * 512 + c0; yw[u] = *(const u32x4*)(Y + o); gwd[u] = *(const u32x4*)(B.G + o); vwd[u] = *(const u32x4*)(B.V + o); c3v[u] = B.C3[(mb + 2048 * u) * 8 + h]; }
        const f32x4 w0 = *(const f32x4*)(lnw + c0), w1 = *(const f32x4*)(lnw + c0 + 4), b0 = *(const f32x4*)(lnb + c0), b1 = *(const f32x4*)(lnb + c0 + 4);
#pragma unroll
        for (int u = 0; u < 2; ++u) {
            const size_t o = (size_t)(mb + 2048 * u) * 512 + c0;
            f32x4 y0, y1, g0, g1, v0, v1;
            unpack8(yw[u], y0, y1); unpack8(gwd[u], g0, g1); unpack8(vwd[u], v0, v1);
            const float c3 = c3v[u];
            const float mean = rsum8((y0[0] + y0[1]) + (y0[2] + y0[3]) + (y1[0] + y1[1]) + (y1[2] + y1[3])) * (1.0f / 64.0f);
            const f32x4 d0 = y0 - mean, d1 = y1 - mean;
            const float var = rsum8(d0[0] * d0[0] + d0[1] * d0[1] + d0[2] * d0[2] + d0[3] * d0[3] + d1[0] * d1[0] + d1[1] * d1[1] + d1[2] * d1[2] + d1[3] * d1[3]) * (1.0f / 64.0f);
            const float rstd = rsqrtf(var + 64e-5f);
            const f32x4 r0 = (d0 * rstd * w0 + b0 + c3 * v0) * g0, r1 = (d1 * rstd * w1 + b1 + c3 * v1) * g1;
            *(u32x4*)(Y + o) = pack8(r0, r1);
        }
    }
    const float* hlb = IN(21);
    for (int it = bid_s(); it < 1024; it += gridDim.x) hgC_item(B, l, it, shm, hlb, hn);
}

__device__ __forceinline__ void phase8(int l, int s) {
    const Bufs B = make_bufs(WSP(), l);
    const float* cw = IN(27) + (size_t)l * 3 * 5632; const float* cb = IN(28) + (size_t)l * 5632;
    const int tid = tid_v();
    if (tid >= 352) return;
    const int j0 = tid * 8;
    f32x4 wg[3][2], wv[3][2], bg[2], bv[2];
#pragma unroll
    for (int e = 0; e < 2; ++e) {
        bg[e] = *(const f32x4*)(cb + j0 + 4 * e); bv[e] = *(const f32x4*)(cb + 2816 + j0 + 4 * e);
#pragma unroll
        for (int tap = 0; tap < 3; ++tap) { wg[tap][e] = *(const f32x4*)(cw + (size_t)tap * 5632 + j0 + 4 * e); wv[tap][e] = *(const f32x4*)(cw + (size_t)tap * 5632 + 2816 + j0 + 4 * e); }
    }
    const u32x4 zero4 = {0u, 0u, 0u, 0u};
    for (int blk = bid_s(); blk < MS / 64; blk += gridDim.x) {
        const int mbeg = blk * 64, b = mbeg >> 11, tl0 = mbeg & 2047;
        const bf16_t* ub = B.bufU + (size_t)mbeg * 5632 + j0;
        u32x4 hg1, hv1, hg2, hv2;
        if (tl0 > 0) { hg1 = *(const u32x4*)(ub - 5632); hv1 = *(const u32x4*)(ub - 5632 + 2816); hg2 = *(const u32x4*)(ub - 2 * 5632); hv2 = *(const u32x4*)(ub - 2 * 5632 + 2816); }
        else if (s == 1) { const bf16_t* sp = B.saveU + (size_t)(b * 2) * 5632 + j0; hg1 = *(const u32x4*)(sp + 5632); hv1 = *(const u32x4*)(sp + 5632 + 2816); hg2 = *(const u32x4*)sp; hv2 = *(const u32x4*)(sp + 2816); }
        else { hg1 = zero4; hv1 = zero4; hg2 = zero4; hv2 = zero4; }
        f32x4 g1[2], v1[2], g2[2], v2[2];
        unpack8(hg1, g1[0], g1[1]); unpack8(hv1, v1[0], v1[1]); unpack8(hg2, g2[0], g2[1]); unpack8(hv2, v2[0], v2[1]);
#pragma unroll 1
        for (int r0 = 0; r0 < 64; r0 += 4) {
            u32x4 gw[4], vw[4];
#pragma unroll
            for (int q = 0; q < 4; ++q) { gw[q] = *(const u32x4*)(ub + (size_t)(r0 + q) * 5632); vw[q] = *(const u32x4*)(ub + (size_t)(r0 + q) * 5632 + 2816); }
#pragma unroll
            for (int q = 0; q < 4; ++q) {
                const int m = mbeg + r0 + q, tl = tl0 + r0 + q;
                if (s == 0 && tl >= 2046) { bf16_t* sp = B.saveU + (size_t)(b * 2 + tl - 2046) * 5632 + j0; *(u32x4*)sp = gw[q]; *(u32x4*)(sp + 2816) = vw[q]; }
                f32x4 gc[2], vc[2]; unpack8(gw[q], gc[0], gc[1]); unpack8(vw[q], vc[0], vc[1]);
                f32x4 og[2], ov[2];
#pragma unroll
                for (int e = 0; e < 2; ++e) {
                    og[e] = bg[e] + wg[2][e] * gc[e] + wg[1][e] * g1[e] + wg[0][e] * g2[e];
                    ov[e] = bv[e] + wv[2][e] * vc[e] + wv[1][e] * v1[e] + wv[0][e] * v2[e];
#pragma unroll
                    for (int j = 0; j < 4; ++j) og[e][j] = gelu_t(og[e][j]) * ov[e][j];
                    g2[e] = g1[e]; v2[e] = v1[e]; g1[e] = gc[e]; v1[e] = vc[e];
                }
                *(u32x4*)(B.act + (size_t)m * 2816 + j0) = pack8(og[0], og[1]);
            }
        }
    }
}

__device__ __forceinline__ void phase_final() {
    float* outp = OUTP();
    const int lane = tid_v() & 63, gw = bid_s() * 8 + (tid_v() >> 6);
    const f32x4* gm = (const f32x4*)IN(33);
    for (int mb = gw; mb < 32768; mb += 4096) {
        f32x4 v[2][4];
#pragma unroll
        for (int u = 0; u < 2; ++u) { const f32x4* xr = (const f32x4*)(outp + (size_t)(mb + 2048 * u) * 1024);
#pragma unroll
            for (int i = 0; i < 4; ++i) v[u][i] = xr[lane + 64 * i]; }
#pragma unroll
        for (int u = 0; u < 2; ++u) { f32x4* xr = (f32x4*)(outp + (size_t)(mb + 2048 * u) * 1024); float sum = 0.f;
#pragma unroll
            for (int i = 0; i < 4; ++i) sum += v[u][i][0] * v[u][i][0] + v[u][i][1] * v[u][i][1] + v[u][i][2] * v[u][i][2] + v[u][i][3] * v[u][i][3];
            sum = wsum(sum);
            const float rs = rsqrtf(sum * (1.0f / 1024.0f) + 1e-6f);
#pragma unroll
            for (int i = 0; i < 4; ++i) xr[lane + 64 * i] = v[u][i] * rs * gm[lane + 64 * i]; }
    }
}

__global__ void __launch_bounds__(512, 2) mega(Params p) {
    extern __shared__ __attribute__((aligned(16))) unsigned char shm[];
    cg::grid_group grid = cg::this_grid();
    PG8_LAS unsigned char* lds = (PG8_LAS unsigned char*)shm;
    constexpr int G = 256; const int c = (int)bid_s();
    volatile PG8_LAS unsigned* bst = (volatile PG8_LAS unsigned*)(lds + 131072);
    if (tid_v() < 4) bst[tid_v()] = 0u;
    __syncthreads();
    const XcdBarrier xb = xcd_barrier_post((unsigned*)(WSP() + BAR_OFF), bst);
    phase0(shm);
    grid.sync();
#pragma unroll 1
    for (int ls = 0; ls < 4; ++ls) {
        const int l = ls >> 1, s = ls & 1;
        phaseX(l, s);
        xcd_barrier(xb);
        {
            const Bufs B = make_bufs(WSP(), l);
            StaticOrder S; S.init(MS, 4864, G, c);
            EpiProj E{B.ss0, B.bufA, B.bufB, B.bufC, B.bufD};
            gemm_phase(lds, Gemm{B.xb, B.W + oWin, MS, 4864, 1024}, S, E);
        }
        xcd_barrier(xb);
        phase2(l, s, shm);
        xcd_barrier(xb);
        scans(l, s, shm);
        xcd_barrier(xb);
        phase4(l, shm);
        xcd_barrier(xb);
        {
            const Bufs B = make_bufs(WSP(), l);
            StaticOrder S0; S0.init(MS, 1024, G, c);
            P5Order S; S0.next(0, S.t); S.xb = B.xb; S.Wg = B.W + oWin + (size_t)4864 * 1024; S.br = B.br; S.Wb = B.W + oWb; S.brs = VEC_STRIDE;
            EpiP5 E{B.ss0, B.gates, B.mrg, B.mb};
            gemm_phase_x(lds, S, E);
        }
        xcd_barrier(xb);
        {
            const Bufs B = make_bufs(WSP(), l);
            StaticOrder S; S.init(MS, 1024, G, c);
            EpiRes E{l == 0 ? IN(0) : OUTP(), OUTP(), B.xb, B.ss1, s};
            gemm_phase(lds, Gemm{B.mb, B.W + oWo, MS, 1024, launder_s(1024)}, S, E);
        }
        xcd_barrier(xb);
        {
            const Bufs B = make_bufs(WSP(), l);
            StaticOrder S; S.init(MS, 5632, G, c);
            EpiBf<0> E{B.ss1, B.bufU, 5632};
            gemm_phase(lds, Gemm{B.xb, B.W + oWup, MS, 5632, launder_s(1024)}, S, E);
        }
        xcd_barrier(xb);
        phase8(l, s);
        xcd_barrier(xb);
        {
            const Bufs B = make_bufs(WSP(), l);
            StaticOrder S; S.init(MS, 1024, G, c);
            EpiRes E{OUTP(), OUTP(), B.xb, B.ss2, s};
            gemm_phase(lds, Gemm{B.act, B.W + oWd, MS, 1024, launder_s(2816)}, S, E);
        }
        xcd_barrier(xb);
        {
            const Bufs B = make_bufs(WSP(), l);
            StaticOrder S0; S0.init(MS, 1024, G, c);
            P10Order S; S0.next(0, S.t); S.pb = B.pb; S.Wp = B.W + oWp; S.xb = B.xb; S.Wg = B.W + oWg;
            EpiP10 E{B.ss2, B.pp, OUTP(), s};
            gemm_phase_x(lds, S, E);
        }
        xcd_barrier(xb);
    }
    phase_final();
}

extern "C" void kernel_launch(void* const* d_in, const int* in_sizes, int n_in, void* d_out, int out_size,
                              void* d_ws, size_t ws_size, hipStream_t stream) {
    constexpr size_t kDynLds = 131072 + 64;
    static int grid_blocks = 0;
    if (!grid_blocks) {
        (void)hipFuncSetAttribute((const void*)mega, hipFuncAttributeMaxDynamicSharedMemorySize, (int)kDynLds);
        int dev = 0, cus = 0, per_cu = 0;
        (void)hipGetDevice(&dev);
        (void)hipDeviceGetAttribute(&cus, hipDeviceAttributeMultiprocessorCount, dev);
        (void)hipOccupancyMaxActiveBlocksPerMultiprocessor(&per_cu, mega, 512, kDynLds);
        grid_blocks = cus * per_cu;
        if (grid_blocks > 256) grid_blocks = 256;
        if (grid_blocks != 256) { fprintf(stderr, "this kernel needs 256 co-resident workgroups, got %d\n", grid_blocks); grid_blocks = 0; }
    }
    Params p{};
    for (int i = 0; i < 34; ++i) p.in[i] = (const float*)d_in[i];
    p.out = (float*)d_out; p.ws = (unsigned char*)d_ws;
    (void)hipMemsetAsync((unsigned char*)d_ws + BAR_OFF, 0, XCD_BAR_WORDS * sizeof(unsigned), stream);
    void* args[] = {&p};
    if (grid_blocks != 256) return;
    hipError_t e = hipLaunchCooperativeKernel((void*)mega, dim3(grid_blocks), dim3(512), args, kDynLds, stream);
    if (e != hipSuccess) fprintf(stderr, "cooperative launch failed: %s (grid %d)\n", hipGetErrorString(e), grid_blocks);
}
```

```cpp
#include <hip/hip_runtime.h>
#include <hip/hip_cooperative_groups.h>
#include <cstdio>
namespace cg = cooperative_groups;

#define PG8_LAS __attribute__((address_space(3)))
typedef unsigned short bf16_t;
typedef short bf16x8 __attribute__((ext_vector_type(8)));
typedef float f32x4 __attribute__((ext_vector_type(4)));
typedef float f32x2 __attribute__((ext_vector_type(2)));
typedef unsigned u32x4 __attribute__((ext_vector_type(4)));
typedef unsigned u32x2 __attribute__((ext_vector_type(2)));
constexpr int BM = 256, BK = 64, HALF = 128, HTB = HALF * BK * 2, STAGE_BYTES = 8 * HTB, NXCD = 8, WGM = 8;

__host__ __device__ __forceinline__ int lds_byte(int r, int c) { const int st = (r >> 4) * 2 + (c >> 5), rr = r & 15, cc = c & 31, ob = rr * 64 + cc * 2; return st * 1024 + (ob ^ (((ob >> 9) & 1) << 5)); }
__host__ __device__ __forceinline__ void stage_rc(int b, int& R, int& C) { const int st = b / 1024, sb = b % 1024, swz = sb ^ (((sb >> 9) & 1) << 5); R = (st >> 1) * 16 + swz / 64; C = (st & 1) * 32 + (swz % 64) / 2; }
__host__ __device__ __forceinline__ int perm32(int rho) { const int n = rho >> 4, i = rho & 15; return 8 * (i >> 2) + 4 * n + (i & 3); }

__device__ __forceinline__ int tid_v() { int t = threadIdx.x; asm volatile("" : "+v"(t)); return t; }
__device__ __forceinline__ int bid_s() { int b = blockIdx.x; asm volatile("" : "+s"(b)); return b; }
struct Unit { int pm, pn; };
struct Gemm { const bf16_t* A; const bf16_t* Bt; int M, N, K; };

struct StaticOrder {
    int nM, nN, nwg, G, c;
    __host__ __device__ void init(int M, int N, int G_, int c_) { nM = M / BM; nN = N / BM; nwg = nM * nN; G = G_; c = c_; }
    __host__ __device__ bool next(int i, Unit& u) const {
        const long L = (long)i * G + c; if (L >= nwg) return false;
        int wgid = (int)L; { const int q = nwg / NXCD, r = nwg % NXCD, xcd = wgid % NXCD, off = wgid / NXCD; wgid = (xcd < r ? xcd * (q + 1) : r * (q + 1) + (xcd - r) * q) + off; }
        const int nig = WGM * nN, gid = wgid / nig, fm = gid * WGM, gsz = (nM - fm) < WGM ? (nM - fm) : WGM;
        u.pm = fm + ((wgid % nig) % gsz); u.pn = (wgid % nig) / gsz; return true;
    }
    __device__ __forceinline__ void a_ready(const Unit&) const {}
    __device__ __forceinline__ void done(const Unit&) const {}
};

typedef __bf16 bf16x2_t __attribute__((ext_vector_type(2)));
__device__ __forceinline__ unsigned cvt_pk_bf16(float lo, float hi) { const f32x2 v = {lo, hi}; return __builtin_bit_cast(unsigned, __builtin_convertvector(v, bf16x2_t)); }
__device__ __forceinline__ float bf2f(bf16_t b) { return __uint_as_float(((unsigned)b) << 16); }
__device__ __forceinline__ float bflo(unsigned w) { return __uint_as_float(w << 16); }
__device__ __forceinline__ float bfhi(unsigned w) { return __uint_as_float(w & 0xffff0000u); }
__device__ __forceinline__ bf16_t f2bf(float f) { unsigned u = __float_as_uint(f); u += 0x7FFFu + ((u >> 16) & 1u); return (bf16_t)(u >> 16); }
__device__ __forceinline__ float sigm(float x) { return __builtin_amdgcn_rcpf(1.0f + __expf(-x)); }
__device__ __forceinline__ float gelu_t(float x) { return x * __builtin_amdgcn_rcpf(1.0f + __expf(-1.5957691216f * (x + 0.044715f * x * x * x))); }
__device__ __forceinline__ float silu_f(float x) { return x * __builtin_amdgcn_rcpf(1.0f + __expf(-x)); }
__device__ __forceinline__ float wsum(float v) {
#pragma unroll
    for (int o = 32; o; o >>= 1) v += __shfl_xor(v, o);
    return v;
}
template <int CTRL> __device__ __forceinline__ float dppf(float v) { return __int_as_float(__builtin_amdgcn_update_dpp(0, __float_as_int(v), CTRL, 0xf, 0xf, true)); }
__device__ __forceinline__ float rsum16(float v) {
    v += dppf<0xB1>(v); v += dppf<0x4E>(v); v += dppf<0x141>(v); v += dppf<0x140>(v); return v;
}

__device__ __forceinline__ u32x4 pack8(const f32x4& v0, const f32x4& v1) { u32x4 w; w.x = cvt_pk_bf16(v0[0], v0[1]); w.y = cvt_pk_bf16(v0[2], v0[3]); w.z = cvt_pk_bf16(v1[0], v1[1]); w.w = cvt_pk_bf16(v1[2], v1[3]); return w; }
__device__ __forceinline__ void unpack8(const u32x4& w, f32x4& v0, f32x4& v1) { v0[0] = bflo(w.x); v0[1] = bfhi(w.x); v0[2] = bflo(w.y); v0[3] = bfhi(w.y); v1[0] = bflo(w.z); v1[1] = bfhi(w.z); v1[2] = bflo(w.w); v1[3] = bfhi(w.w); }

struct EpiProj {
    static constexpr bool PERM = true, AFTER_DRAIN = false;
    const float* ss; bf16_t* bA; bf16_t* bB; bf16_t* bC; bf16_t* bD;
    __device__ __forceinline__ void operator()(const f32x4 (&acc)[2][2][4][2], const Unit& u, int wr, int wc, int fr, int fq) const {
        const int pn = u.pn; bf16_t* base; int ld, coff, act;
        if (pn < 2) { base = bA; ld = 512; coff = pn * 256; act = 0; }
        else if (pn < 9) { base = bB; ld = 1792; coff = (pn - 2) * 256; act = 0; }
        else if (pn < 13) { base = bC; ld = 1024; coff = (pn - 9) * 256; act = 1; }
        else { base = bD; ld = 1536; coff = (pn - 13) * 256; act = pn < 15 ? 2 : (pn < 17 ? 4 : 0); }
        const int row0 = u.pm * BM + wr * 64 + fr, col0 = coff + wc * 32 + 8 * fq;
#pragma unroll
        for (int ai = 0; ai < 2; ++ai)
#pragma unroll
            for (int m = 0; m < 4; ++m) {
                const int row = row0 + ai * HALF + m * 16;
                bf16_t* rowp = base + (size_t)row * ld + col0;
#pragma unroll
                for (int bj = 0; bj < 2; ++bj) {
                    f32x4 v0 = acc[ai][bj][m][0], v1 = acc[ai][bj][m][1];
                    if (act == 1) {
#pragma unroll
                        for (int j = 0; j < 4; ++j) { v0[j] = gelu_t(v0[j]); v1[j] = gelu_t(v1[j]); }
                    } else if (act == 2) {
#pragma unroll
                        for (int j = 0; j < 4; ++j) { v0[j] = silu_f(v0[j]); v1[j] = silu_f(v1[j]); }
                    } else if (act == 4) {
#pragma unroll
                        for (int j = 0; j < 4; ++j) { v0[j] = sigm(-v0[j]); v1[j] = sigm(-v1[j]); }
                    }
                    *(u32x4*)(rowp + bj * HALF) = pack8(v0, v1);
                }
            }
    }
};

template <int ACT  > struct EpiBf {
    static constexpr bool PERM = true, AFTER_DRAIN = false;
    const float* ss; bf16_t* out; int ld;
    __device__ __forceinline__ void operator()(const f32x4 (&acc)[2][2][4][2], const Unit& u, int wr, int wc, int fr, int fq) const {
        const int row0 = u.pm * BM + wr * 64 + fr, col0 = u.pn * BM + wc * 32 + 8 * fq;
#pragma unroll
        for (int ai = 0; ai < 2; ++ai)
#pragma unroll
            for (int m = 0; m < 4; ++m) {
                const int row = row0 + ai * HALF + m * 16;
                const float rs = ss ? rsqrtf(ss[row] * (1.0f / 1024.0f) + 1e-6f) : 1.0f;
                bf16_t* rowp = out + (size_t)row * ld + col0;
#pragma unroll
                for (int bj = 0; bj < 2; ++bj) {
                    f32x4 v0 = acc[ai][bj][m][0] * rs, v1 = acc[ai][bj][m][1] * rs;
                    if (ACT == 3) {
#pragma unroll
                        for (int j = 0; j < 4; ++j) { v0[j] = sigm(v0[j]); v1[j] = sigm(v1[j]); }
                    }
                    *(u32x4*)(rowp + bj * HALF) = pack8(v0, v1);
                }
            }
    }
};

struct EpiBranch {
    static constexpr bool PERM = true, AFTER_DRAIN = false;
    const bf16_t* gates; float* mrg; bf16_t* mb; int kb;
    __device__ __forceinline__ void operator()(const f32x4 (&acc)[2][2][4][2], const Unit& u, int wr, int wc, int fr, int fq) const {
        const int row0 = u.pm * BM + wr * 64 + fr, col0 = u.pn * BM + wc * 32 + 8 * fq;
#pragma unroll
        for (int ai = 0; ai < 2; ++ai)
#pragma unroll
            for (int m = 0; m < 4; ++m) {
                const int row = row0 + ai * HALF + m * 16;
#pragma unroll
                for (int bj = 0; bj < 2; ++bj) {
                    const size_t idx = (size_t)row * 1024 + col0 + bj * HALF;
                    const u32x4 gw = *(const u32x4*)(gates + idx);
                    f32x4 g0, g1; unpack8(gw, g0, g1);
                    f32x4 m0 = {0.f, 0.f, 0.f, 0.f}, m1 = {0.f, 0.f, 0.f, 0.f};
                    if (kb > 0) { m0 = *(const f32x4*)(mrg + idx); m1 = *(const f32x4*)(mrg + idx + 4); }
                    m0 += g0 * acc[ai][bj][m][0]; m1 += g1 * acc[ai][bj][m][1];
                    if (kb < 3) { *(f32x4*)(mrg + idx) = m0; *(f32x4*)(mrg + idx + 4) = m1; }
                    else *(u32x4*)(mb + idx) = pack8(m0, m1);
                }
            }
    }
};

struct EpiRes {
    static constexpr bool PERM = true, AFTER_DRAIN = false;
    const float* xin; float* xout; bf16_t* xb; float* ssn; int s;
    __device__ __forceinline__ void operator()(const f32x4 (&acc)[2][2][4][2], const Unit& u, int wr, int wc, int fr, int fq) const {
        const int row0 = u.pm * BM + wr * 64 + fr, col0 = u.pn * BM + wc * 32 + 8 * fq;
#pragma unroll
        for (int ai = 0; ai < 2; ++ai)
#pragma unroll
            for (int m = 0; m < 4; ++m) {
                const int row = row0 + ai * HALF + m * 16;
                const size_t rowg = (size_t)((row >> 11) * 4096 + s * 2048 + (row & 2047));
                float sq = 0.f;
#pragma unroll
                for (int bj = 0; bj < 2; ++bj) {
                    const size_t gi = rowg * 1024 + col0 + bj * HALF;
                    f32x4 x0 = *(const f32x4*)(xin + gi), x1 = *(const f32x4*)(xin + gi + 4);
                    x0 += acc[ai][bj][m][0]; x1 += acc[ai][bj][m][1];
                    *(f32x4*)(xout + gi) = x0; *(f32x4*)(xout + gi + 4) = x1;
                    *(u32x4*)(xb + (size_t)row * 1024 + col0 + bj * HALF) = pack8(x0, x1);
                    sq += x0[0] * x0[0] + x0[1] * x0[1] + x0[2] * x0[2] + x0[3] * x0[3] + x1[0] * x1[0] + x1[1] * x1[1] + x1[2] * x1[2] + x1[3] * x1[3];
                }
                sq += __shfl_xor(sq, 16); sq += __shfl_xor(sq, 32);
                if (fq == 0) atomicAdd(ssn + row, sq);
            }
    }
};

struct EpiPle {
    static constexpr bool PERM = true, AFTER_DRAIN = false;
    const float* ss; const bf16_t* pp; float* x; int s;
    __device__ __forceinline__ void operator()(const f32x4 (&acc)[2][2][4][2], const Unit& u, int wr, int wc, int fr, int fq) const {
        const int row0 = u.pm * BM + wr * 64 + fr, col0 = u.pn * BM + wc * 32 + 8 * fq;
#pragma unroll
        for (int ai = 0; ai < 2; ++ai)
#pragma unroll
            for (int m = 0; m < 4; ++m) {
                const int row = row0 + ai * HALF + m * 16;
                const size_t rowg = (size_t)((row >> 11) * 4096 + s * 2048 + (row & 2047));
                const float rs = rsqrtf(ss[row] * (1.0f / 1024.0f) + 1e-6f);
#pragma unroll
                for (int bj = 0; bj < 2; ++bj) {
                    const size_t gi = rowg * 1024 + col0 + bj * HALF;
                    const u32x4 pw = *(const u32x4*)(pp + (size_t)row * 1024 + col0 + bj * HALF);
                    f32x4 p0, p1; unpack8(pw, p0, p1);
                    f32x4 x0 = *(const f32x4*)(x + gi), x1 = *(const f32x4*)(x + gi + 4);
#pragma unroll
                    for (int j = 0; j < 4; ++j) { x0[j] += p0[j] * sigm(acc[ai][bj][m][0][j] * rs); x1[j] += p1[j] * sigm(acc[ai][bj][m][1][j] * rs); }
                    *(f32x4*)(x + gi) = x0; *(f32x4*)(x + gi + 4) = x1;
                }
            }
    }
};

struct UnitX { int pm, pn; const bf16_t* A; const bf16_t* Bt; int K; int kind; int kb; };
template <class Epi, class Sched>
__device__ __forceinline__ void gemm_phase(PG8_LAS unsigned char* lds, const Gemm g, const Sched& S, const Epi& E) {
    const int tid = tid_v(), wid = __builtin_amdgcn_readfirstlane(tid >> 6), lane = tid & 63, wr = wid >> 2, wc = wid & 3, fr = lane & 15, fq = lane >> 4;
    const int K = g.K, nt = K / BK;
    unsigned voffA[2], voffB[2];
#pragma unroll
    for (int i = 0; i < 2; ++i) { int R, C; stage_rc(tid * 16 + i * 8192, R, C); const int Rb = Epi::PERM ? ((R & ~31) + perm32(R & 31)) : R;
        voffA[i] = (unsigned)(R * K + C) * 2u; voffB[i] = (unsigned)(Rb * K + C) * 2u; }
    const size_t kstep = (size_t)(BK * 2);
    const size_t hstep = (size_t)HALF * K * 2;
    const size_t tstep = 2 * hstep;
    const unsigned ldsw = (unsigned)wid * 1024u;
    const int aoff = lds_byte(wr * 64 + fr, fq * 8), boff = lds_byte(wc * 32 + fr, fq * 8);
#define PG8_SA(b, h) (((b) * 2 + (h)) * HTB)
#define PG8_SB(b, h) ((4 + (b) * 2 + (h)) * HTB)
#define PG8_STAGE(bufoff, gbase, voff) do { _Pragma("unroll") for (int _i = 0; _i < 2; ++_i) \
        __builtin_amdgcn_global_load_lds((const unsigned*)((const char*)(gbase) + (voff)[_i]), (PG8_LAS unsigned*)(lds + (bufoff) + ldsw + _i * 8192), 16, 0, 0); } while (0)
#define PG8_LDA(dst, b, h) do { _Pragma("unroll") for (int m = 0; m < 4; ++m) _Pragma("unroll") for (int k = 0; k < 2; ++k) dst[m][k] = *(const PG8_LAS bf16x8*)(lds + PG8_SA(b, h) + aoff + m * 2048 + k * 1024); } while (0)
#define PG8_LDB(dst, b, h) do { _Pragma("unroll") for (int n = 0; n < 2; ++n) _Pragma("unroll") for (int k = 0; k < 2; ++k) dst[n][k] = *(const PG8_LAS bf16x8*)(lds + PG8_SB(b, h) + boff + n * 2048 + k * 1024); } while (0)
#define PG8_MMA(ai, bj, At, Bt) do { __builtin_amdgcn_s_setprio(1); _Pragma("unroll") for (int m = 0; m < 4; ++m) _Pragma("unroll") for (int n = 0; n < 2; ++n) _Pragma("unroll") for (int k = 0; k < 2; ++k) \
        acc[ai][bj][m][n] = __builtin_amdgcn_mfma_f32_16x16x32_bf16(Bt[n][k], At[m][k], acc[ai][bj][m][n], 0, 0, 0); __builtin_amdgcn_s_setprio(0); } while (0)
#define PG8_WAIT_V(n) asm volatile("s_waitcnt vmcnt(" #n ")" ::: "memory")
#define PG8_WAIT_L(n) asm volatile("s_waitcnt lgkmcnt(" #n ")" ::: "memory")
#define PG8_BAR __builtin_amdgcn_s_barrier()
#define PG8_SCHED __builtin_amdgcn_sched_barrier(0)
    Unit cur, nxt; int ui = 0;
    if (!S.next(0, cur)) return;
    f32x4 acc[2][2][4][2];
#pragma unroll
    for (int a = 0; a < 2; ++a)
#pragma unroll
        for (int b = 0; b < 2; ++b)
#pragma unroll
            for (int m = 0; m < 4; ++m)
#pragma unroll
                for (int n = 0; n < 2; ++n) acc[a][b][m][n] = (f32x4){0.f, 0.f, 0.f, 0.f};
    bf16x8 At[4][2], B0[2][2], B1[2][2];
    const char* cA = (const char*)g.A + (size_t)cur.pm * tstep; const char* cB = (const char*)g.Bt + (size_t)cur.pn * tstep;
    S.a_ready(cur);
    PG8_STAGE(PG8_SB(0, 0), cB, voffB); PG8_STAGE(PG8_SA(0, 0), cA, voffA); PG8_STAGE(PG8_SB(0, 1), cB + hstep, voffB); PG8_STAGE(PG8_SA(0, 1), cA + hstep, voffA);
    if (wr == 1) PG8_BAR;
    PG8_WAIT_V(4); PG8_BAR;
    PG8_STAGE(PG8_SB(1, 0), cB + kstep, voffB); PG8_STAGE(PG8_SA(1, 0), cA + kstep, voffA); PG8_STAGE(PG8_SB(1, 1), cB + hstep + kstep, voffB);
    PG8_WAIT_V(6); PG8_BAR;
    for (;;) {
        const bool has_next = S.next(ui + 1, nxt);
        const char* nA = has_next ? (const char*)g.A + (size_t)nxt.pm * tstep : cA; const char* nB = has_next ? (const char*)g.Bt + (size_t)nxt.pn * tstep : cB;
        for (int t = 0; t < nt; t += 2) {
            const bool last = (t == nt - 2);
            const char* a1 = cA + (size_t)(t + 1) * kstep;
            const char* a2 = last ? nA : cA + (size_t)(t + 2) * kstep; const char* b2 = last ? nB : cB + (size_t)(t + 2) * kstep;
            const char* a3 = a2 + kstep; const char* b3 = b2 + kstep;
            if (last && has_next) S.a_ready(nxt);
            PG8_LDB(B0, 0, 0); PG8_SCHED; PG8_LDA(At, 0, 0); PG8_STAGE(PG8_SA(1, 1), a1 + hstep, voffA);
            PG8_WAIT_L(8); PG8_BAR; PG8_WAIT_L(0); PG8_MMA(0, 0, At, B0); PG8_BAR; PG8_SCHED;
            PG8_LDB(B1, 0, 1); PG8_STAGE(PG8_SB(0, 0), b2, voffB);
            PG8_BAR; PG8_WAIT_L(0); PG8_MMA(0, 1, At, B1); PG8_BAR;
            PG8_LDA(At, 0, 1); PG8_STAGE(PG8_SA(0, 0), a2, voffA);
            PG8_BAR; PG8_WAIT_L(0); PG8_MMA(1, 0, At, B0); PG8_BAR; PG8_SCHED;
            PG8_STAGE(PG8_SB(0, 1), b2 + hstep, voffB);
            PG8_WAIT_V(6); PG8_BAR; PG8_MMA(1, 1, At, B1); PG8_BAR;
            PG8_LDB(B0, 1, 0); PG8_SCHED; PG8_LDA(At, 1, 0); PG8_STAGE(PG8_SA(0, 1), a2 + hstep, voffA);
            PG8_WAIT_L(8); PG8_BAR; PG8_WAIT_L(0); PG8_MMA(0, 0, At, B0); PG8_BAR; PG8_SCHED;
            PG8_LDB(B1, 1, 1); PG8_STAGE(PG8_SB(1, 0), b3, voffB);
            PG8_BAR; PG8_WAIT_L(0); PG8_MMA(0, 1, At, B1); PG8_BAR;
            PG8_LDA(At, 1, 1); PG8_STAGE(PG8_SA(1, 0), a3, voffA);
            PG8_BAR; PG8_WAIT_L(0); PG8_MMA(1, 0, At, B0); PG8_BAR; PG8_SCHED;
            PG8_STAGE(PG8_SB(1, 1), b3 + hstep, voffB);
            PG8_WAIT_V(6); PG8_BAR; PG8_MMA(1, 1, At, B1); PG8_BAR;
        }
        if constexpr (!Epi::AFTER_DRAIN) { E(acc, cur, wr, wc, fr, fq); S.done(cur); }
        if (!has_next) break;
#pragma unroll
        for (int a = 0; a < 2; ++a)
#pragma unroll
            for (int b = 0; b < 2; ++b)
#pragma unroll
                for (int m = 0; m < 4; ++m)
#pragma unroll
                    for (int n = 0; n < 2; ++n) acc[a][b][m][n] = (f32x4){0.f, 0.f, 0.f, 0.f};
        cur = nxt; cA = nA; cB = nB; ++ui;
    }
    PG8_WAIT_V(0);
    if (wr == 0) PG8_BAR;
    PG8_BAR;
    if constexpr (Epi::AFTER_DRAIN) { E.fused(acc, cur, wr, wc, fr, fq, lds, wid, lane); S.done(cur); }
#undef PG8_SA
#undef PG8_SB
#undef PG8_STAGE
#undef PG8_LDA
#undef PG8_LDB
#undef PG8_MMA
#undef PG8_WAIT_V
#undef PG8_WAIT_L
#undef PG8_BAR
#undef PG8_SCHED
}

template <class Epi, class Sched>
__device__ __forceinline__ void gemm_phase_x(PG8_LAS unsigned char* lds, const Sched& S, const Epi& E) {
    const int tid = tid_v(), wid = __builtin_amdgcn_readfirstlane(tid >> 6), lane = tid & 63, wr = wid >> 2, wc = wid & 3, fr = lane & 15, fq = lane >> 4;
    UnitX cur, nxt; int ui = 0;
    if (!S.next(0, cur)) return;
    int K = cur.K, nt = K / BK;
    unsigned voffA[2], voffB[2], nvoffA[2], nvoffB[2];
#pragma unroll
    for (int i = 0; i < 2; ++i) { int R, C; stage_rc(tid * 16 + i * 8192, R, C); const int Rb = Epi::PERM ? ((R & ~31) + perm32(R & 31)) : R;
        voffA[i] = (unsigned)(R * K + C) * 2u; voffB[i] = (unsigned)(Rb * K + C) * 2u; }
    const size_t kstep = (size_t)(BK * 2);
    size_t hstep = (size_t)HALF * K * 2;
    size_t tstep = 2 * hstep;
    const unsigned ldsw = (unsigned)wid * 1024u;
    const int aoff = lds_byte(wr * 64 + fr, fq * 8), boff = lds_byte(wc * 32 + fr, fq * 8);
#define PG8_SA(b, h) (((b) * 2 + (h)) * HTB)
#define PG8_SB(b, h) ((4 + (b) * 2 + (h)) * HTB)
#define PG8_STAGE(bufoff, gbase, voff) do { _Pragma("unroll") for (int _i = 0; _i < 2; ++_i) \
        __builtin_amdgcn_global_load_lds((const unsigned*)((const char*)(gbase) + (voff)[_i]), (PG8_LAS unsigned*)(lds + (bufoff) + ldsw + _i * 8192), 16, 0, 0); } while (0)
#define PG8_LDA(dst, b, h) do { _Pragma("unroll") for (int m = 0; m < 4; ++m) _Pragma("unroll") for (int k = 0; k < 2; ++k) dst[m][k] = *(const PG8_LAS bf16x8*)(lds + PG8_SA(b, h) + aoff + m * 2048 + k * 1024); } while (0)
#define PG8_LDB(dst, b, h) do { _Pragma("unroll") for (int n = 0; n < 2; ++n) _Pragma("unroll") for (int k = 0; k < 2; ++k) dst[n][k] = *(const PG8_LAS bf16x8*)(lds + PG8_SB(b, h) + boff + n * 2048 + k * 1024); } while (0)
#define PG8_MMA(ai, bj, At, Bt) do { __builtin_amdgcn_s_setprio(1); _Pragma("unroll") for (int m = 0; m < 4; ++m) _Pragma("unroll") for (int n = 0; n < 2; ++n) _Pragma("unroll") for (int k = 0; k < 2; ++k) \
        acc[ai][bj][m][n] = __builtin_amdgcn_mfma_f32_16x16x32_bf16(Bt[n][k], At[m][k], acc[ai][bj][m][n], 0, 0, 0); __builtin_amdgcn_s_setprio(0); } while (0)
#define PG8_WAIT_V(n) asm volatile("s_waitcnt vmcnt(" #n ")" ::: "memory")
#define PG8_WAIT_L(n) asm volatile("s_waitcnt lgkmcnt(" #n ")" ::: "memory")
#define PG8_BAR __builtin_amdgcn_s_barrier()
#define PG8_SCHED __builtin_amdgcn_sched_barrier(0)
    f32x4 acc[2][2][4][2];
#pragma unroll
    for (int a = 0; a < 2; ++a)
#pragma unroll
        for (int b = 0; b < 2; ++b)
#pragma unroll
            for (int m = 0; m < 4; ++m)
#pragma unroll
                for (int n = 0; n < 2; ++n) acc[a][b][m][n] = (f32x4){0.f, 0.f, 0.f, 0.f};
    bf16x8 At[4][2], B0[2][2], B1[2][2];
    const char* cA = (const char*)cur.A + (size_t)cur.pm * tstep; const char* cB = (const char*)cur.Bt + (size_t)cur.pn * tstep;
    S.a_ready(cur);
    PG8_STAGE(PG8_SB(0, 0), cB, voffB); PG8_STAGE(PG8_SA(0, 0), cA, voffA); PG8_STAGE(PG8_SB(0, 1), cB + hstep, voffB); PG8_STAGE(PG8_SA(0, 1), cA + hstep, voffA);
    if (wr == 1) PG8_BAR;
    PG8_WAIT_V(4); PG8_BAR;
    PG8_STAGE(PG8_SB(1, 0), cB + kstep, voffB); PG8_STAGE(PG8_SA(1, 0), cA + kstep, voffA); PG8_STAGE(PG8_SB(1, 1), cB + hstep + kstep, voffB);
    PG8_WAIT_V(6); PG8_BAR;
    for (;;) {
        const bool has_next = S.next(ui + 1, nxt);
        const int nK = has_next ? nxt.K : K; const size_t nhstep = (size_t)HALF * nK * 2;
#pragma unroll
        for (int i = 0; i < 2; ++i) { int R, C; stage_rc(tid * 16 + i * 8192, R, C); const int Rb = Epi::PERM ? ((R & ~31) + perm32(R & 31)) : R;
            nvoffA[i] = (unsigned)(R * nK + C) * 2u; nvoffB[i] = (unsigned)(Rb * nK + C) * 2u; }
        const char* nA = has_next ? (const char*)nxt.A + (size_t)nxt.pm * (2 * nhstep) : cA; const char* nB = has_next ? (const char*)nxt.Bt + (size_t)nxt.pn * (2 * nhstep) : cB;
        for (int t = 0; t < nt; t += 2) {
            const bool last = (t == nt - 2);
            const char* a1 = cA + (size_t)(t + 1) * kstep;
            const char* a2 = last ? nA : cA + (size_t)(t + 2) * kstep; const char* b2 = last ? nB : cB + (size_t)(t + 2) * kstep;
            const char* a3 = a2 + kstep; const char* b3 = b2 + kstep;
            const size_t hs2 = last ? nhstep : hstep;
            if (last && has_next) S.a_ready(nxt);
            PG8_LDB(B0, 0, 0); PG8_SCHED; PG8_LDA(At, 0, 0); PG8_STAGE(PG8_SA(1, 1), a1 + hstep, voffA);
            if (last) {
#pragma unroll
                for (int i = 0; i < 2; ++i) { voffA[i] = nvoffA[i]; voffB[i] = nvoffB[i]; } }
            PG8_WAIT_L(8); PG8_BAR; PG8_WAIT_L(0); PG8_MMA(0, 0, At, B0); PG8_BAR; PG8_SCHED;
            PG8_LDB(B1, 0, 1); PG8_STAGE(PG8_SB(0, 0), b2, voffB);
            PG8_BAR; PG8_WAIT_L(0); PG8_MMA(0, 1, At, B1); PG8_BAR;
            PG8_LDA(At, 0, 1); PG8_STAGE(PG8_SA(0, 0), a2, voffA);
            PG8_BAR; PG8_WAIT_L(0); PG8_MMA(1, 0, At, B0); PG8_BAR; PG8_SCHED;
            PG8_STAGE(PG8_SB(0, 1), b2 + hs2, voffB);
            PG8_WAIT_V(6); PG8_BAR; PG8_MMA(1, 1, At, B1); PG8_BAR;
            PG8_LDB(B0, 1, 0); PG8_SCHED; PG8_LDA(At, 1, 0); PG8_STAGE(PG8_SA(0, 1), a2 + hs2, voffA);
            PG8_WAIT_L(8); PG8_BAR; PG8_WAIT_L(0); PG8_MMA(0, 0, At, B0); PG8_BAR; PG8_SCHED;
            PG8_LDB(B1, 1, 1); PG8_STAGE(PG8_SB(1, 0), b3, voffB);
            PG8_BAR; PG8_WAIT_L(0); PG8_MMA(0, 1, At, B1); PG8_BAR;
            PG8_LDA(At, 1, 1); PG8_STAGE(PG8_SA(1, 0), a3, voffA);
            PG8_BAR; PG8_WAIT_L(0); PG8_MMA(1, 0, At, B0); PG8_BAR; PG8_SCHED;
            PG8_STAGE(PG8_SB(1, 1), b3 + hs2, voffB);
            PG8_WAIT_V(6); PG8_BAR; PG8_MMA(1, 1, At, B1); PG8_BAR;
        }
        if constexpr (!Epi::AFTER_DRAIN) { E(acc, cur, wr, wc, fr, fq); S.done(cur); }
        if (!has_next) break;
#pragma unroll
        for (int a = 0; a < 2; ++a)
#pragma unroll
            for (int b = 0; b < 2; ++b)
#pragma unroll
                for (int m = 0; m < 4; ++m)
#pragma unroll
                    for (int n = 0; n < 2; ++n) acc[a][b][m][n] = (f32x4){0.f, 0.f, 0.f, 0.f};
        cur = nxt; cA = nA; cB = nB; ++ui; K = nK; nt = K / BK; hstep = nhstep; tstep = 2 * hstep;
    }
    PG8_WAIT_V(0);
    if (wr == 0) PG8_BAR;
    PG8_BAR;
    if constexpr (Epi::AFTER_DRAIN) { E.fused(acc, cur, wr, wc, fr, fq, lds, wid, lane); S.done(cur); }
#undef PG8_SA
#undef PG8_SB
#undef PG8_STAGE
#undef PG8_LDA
#undef PG8_LDB
#undef PG8_MMA
#undef PG8_WAIT_V
#undef PG8_WAIT_L
#undef PG8_BAR
#undef PG8_SCHED
}

struct P5Order {
    Unit t; const bf16_t* xb; const bf16_t* Wg; const bf16_t* br; const bf16_t* Wb; size_t brs;
    __device__ __forceinline__ bool next(int i, UnitX& u) const {
        if (i >= 8) return false;
        const int kb = i >> 1; u.pm = t.pm; u.pn = t.pn; u.kb = kb; u.kind = i & 1;
        if ((i & 1) == 0) { u.A = xb; u.Bt = Wg + (size_t)kb * 1024 * 1024; u.K = 1024; }
        else { u.A = br + (size_t)kb * brs; u.Bt = Wb + (size_t)kb * 1024 * 512; u.K = 512; }
        return true;
    }
    __device__ __forceinline__ void a_ready(const UnitX&) const {}
    __device__ __forceinline__ void done(const UnitX&) const {}
};
struct EpiP5 {
    static constexpr bool PERM = true, AFTER_DRAIN = false;
    const float* ss; bf16_t* gates; float* mrg; bf16_t* mb;
    __device__ __forceinline__ void operator()(const f32x4 (&acc)[2][2][4][2], const UnitX& u, int wr, int wc, int fr, int fq) const {
        const int row0 = u.pm * BM + wr * 64 + fr, col0 = u.pn * BM + wc * 32 + 8 * fq, kb = u.kb;
        if (u.kind == 0) {
#pragma unroll
            for (int ai = 0; ai < 2; ++ai)
#pragma unroll
                for (int m = 0; m < 4; ++m) {
                    const int row = row0 + ai * HALF + m * 16;
#pragma unroll
                    for (int bj = 0; bj < 2; ++bj) {
                        f32x4 v0 = acc[ai][bj][m][0], v1 = acc[ai][bj][m][1];
#pragma unroll
                        for (int j = 0; j < 4; ++j) { v0[j] = sigm(v0[j]); v1[j] = sigm(v1[j]); }
                        *(u32x4*)(gates + (size_t)row * 1024 + col0 + bj * HALF) = pack8(v0, v1);
                    }
                }
        } else {
#pragma unroll
            for (int ai = 0; ai < 2; ++ai)
#pragma unroll
                for (int m = 0; m < 4; ++m) {
                    const int row = row0 + ai * HALF + m * 16;
#pragma unroll
                    for (int bj = 0; bj < 2; ++bj) {
                        const size_t idx = (size_t)row * 1024 + col0 + bj * HALF;
                        f32x4 g0, g1; unpack8(*(const u32x4*)(gates + idx), g0, g1);
                        f32x4 m0 = {0.f, 0.f, 0.f, 0.f}, m1 = {0.f, 0.f, 0.f, 0.f};
                        if (kb > 0) { m0 = *(const f32x4*)(mrg + idx); m1 = *(const f32x4*)(mrg + idx + 4); }
                        m0 += g0 * acc[ai][bj][m][0]; m1 += g1 * acc[ai][bj][m][1];
                        if (kb < 3) { *(f32x4*)(mrg + idx) = m0; *(f32x4*)(mrg + idx + 4) = m1; }
                        else *(u32x4*)(mb + idx) = pack8(m0, m1);
                    }
                }
        }
    }
};
struct P10Order {
    Unit t; const bf16_t* pb; const bf16_t* Wp; const bf16_t* xb; const bf16_t* Wg;
    __device__ __forceinline__ bool next(int i, UnitX& u) const {
        if (i >= 2) return false;
        u.pm = t.pm; u.pn = t.pn; u.kb = 0; u.kind = i;
        if (i == 0) { u.A = pb; u.Bt = Wp; u.K = 256; } else { u.A = xb; u.Bt = Wg; u.K = 1024; }
        return true;
    }
    __device__ __forceinline__ void a_ready(const UnitX&) const {}
    __device__ __forceinline__ void done(const UnitX&) const {}
};
struct EpiP10 {
    static constexpr bool PERM = true, AFTER_DRAIN = false;
    const float* ss; bf16_t* pp; float* x; int s;
    __device__ __forceinline__ void operator()(const f32x4 (&acc)[2][2][4][2], const UnitX& u, int wr, int wc, int fr, int fq) const {
        const int row0 = u.pm * BM + wr * 64 + fr, col0 = u.pn * BM + wc * 32 + 8 * fq;
#pragma unroll
        for (int ai = 0; ai < 2; ++ai)
#pragma unroll
            for (int m = 0; m < 4; ++m) {
                const int row = row0 + ai * HALF + m * 16;
                if (u.kind == 0) {
#pragma unroll
                    for (int bj = 0; bj < 2; ++bj) *(u32x4*)(pp + (size_t)row * 1024 + col0 + bj * HALF) = pack8(acc[ai][bj][m][0], acc[ai][bj][m][1]);
                } else {
                    const size_t rowg = (size_t)((row >> 11) * 4096 + s * 2048 + (row & 2047));
                    const float rs = rsqrtf(ss[row] * (1.0f / 1024.0f) + 1e-6f);
#pragma unroll
                    for (int bj = 0; bj < 2; ++bj) {
                        const size_t gi = rowg * 1024 + col0 + bj * HALF;
                        f32x4 p0, p1; unpack8(*(const u32x4*)(pp + (size_t)row * 1024 + col0 + bj * HALF), p0, p1);
                        f32x4 x0 = *(const f32x4*)(x + gi), x1 = *(const f32x4*)(x + gi + 4);
#pragma unroll
                        for (int j = 0; j < 4; ++j) { x0[j] += p0[j] * sigm(acc[ai][bj][m][0][j] * rs); x1[j] += p1[j] * sigm(acc[ai][bj][m][1][j] * rs); }
                        *(f32x4*)(x + gi) = x0; *(f32x4*)(x + gi + 4) = x1;
                    }
                }
            }
    }
};

#define XB_TMO      128
#define XB_XCNT(j)  (256  + 64 * (j))
#define XB_XSUB(j)  (1280 + 64 * (j))
#define XB_XGEN(j)  (2304 + 64 * (j))
#define XB_TOP      3328
#define XB_TOPGEN   3392
#define XCD_BAR_WORDS 3456
#define XB_SPIN_CAP (1u << 18)
#define LAS PG8_LAS

__device__ __forceinline__ unsigned xb_ld(unsigned* p)              { return __hip_atomic_load(p, __ATOMIC_RELAXED, __HIP_MEMORY_SCOPE_AGENT); }
__device__ __forceinline__ unsigned xb_add(unsigned* p, unsigned v) { return __hip_atomic_fetch_add(p, v, __ATOMIC_RELAXED, __HIP_MEMORY_SCOPE_AGENT); }
__device__ __forceinline__ unsigned xb_xcc_id() { return (unsigned)__builtin_amdgcn_s_getreg((3 << 11) | 20) & 0xFu; }
#define XB_SPIN(cond, bar) do { unsigned _sp = 0; while (cond) { __builtin_amdgcn_s_sleep(1); \
    if ((++_sp & 255u) == 0u) { if (xb_ld(&(bar)[XB_TMO])) break; if (_sp > XB_SPIN_CAP) { atomicAdd(&(bar)[XB_TMO], 1u); break; } } } } while (0)

struct XcdBarrier {
    unsigned* bar; unsigned x;
    volatile LAS unsigned* st;
};

__device__ __forceinline__ XcdBarrier xcd_barrier_post(unsigned* bar, volatile LAS unsigned* st) {
    XcdBarrier b; b.bar = bar; b.x = xb_xcc_id(); b.st = st;
    if (threadIdx.x == 0) (void)xb_add(&bar[XB_XCNT(b.x)], 1u);
    return b;
}
__device__ __forceinline__ void xcd_barrier_complete(unsigned* bar, unsigned x, unsigned& nloc, unsigned& nx) {
    const unsigned G = gridDim.x * gridDim.y * gridDim.z;
    unsigned sum, cnt, mine, sp = 0u;
    for (;;) {
        sum = 0u; cnt = 0u; mine = 0u;
#pragma unroll
        for (unsigned j = 0; j < 16; ++j) { const unsigned c = xb_ld(&bar[XB_XCNT(j)]); sum += c; cnt += (c > 0u) ? 1u : 0u; mine = (j == x) ? c : mine; }
        if (sum == G) break;
        __builtin_amdgcn_s_sleep(1);
        if ((++sp & 255u) == 0u) { if (xb_ld(&bar[XB_TMO])) break; if (sp > XB_SPIN_CAP) { atomicAdd(&bar[XB_TMO], 1u); break; } }
    }
    nloc = mine > 0u ? mine : 1u; nx = cnt > 0u ? cnt : 1u;
}

__device__ __forceinline__ void xcd_barrier(const XcdBarrier& b) {
    asm volatile("s_waitcnt vmcnt(0)" ::: "memory");
    __syncthreads();
    if (threadIdx.x == 0) {
        unsigned* bar = b.bar;
        __builtin_amdgcn_s_waitcnt(0);
        unsigned nloc = b.st[0], nx = b.st[1];
        if (nloc == 0u) { xcd_barrier_complete(bar, b.x, nloc, nx); b.st[0] = nloc; b.st[1] = nx; }
        const unsigned old = xb_add(&bar[XB_XSUB(b.x)], 1u);
        const unsigned gen = old / nloc;
        if (old + 1u == (gen + 1u) * nloc) {
            __builtin_amdgcn_fence(__ATOMIC_RELEASE, "agent");
            asm volatile("s_waitcnt vmcnt(0)" ::: "memory");
            const unsigned og = xb_add(&bar[XB_TOP], 1u);
            const unsigned tg = og / nx;
            if (og + 1u == (tg + 1u) * nx) xb_add(&bar[XB_TOPGEN], 1u);
            else XB_SPIN(xb_ld(&bar[XB_TOPGEN]) == tg, bar);
            __builtin_amdgcn_fence(__ATOMIC_ACQUIRE, "agent");
            xb_add(&bar[XB_XGEN(b.x)], 1u);
            asm volatile("s_waitcnt vmcnt(0)" ::: "memory");
        } else {
            XB_SPIN(xb_ld(&bar[XB_XGEN(b.x)]) == gen, bar);
            __builtin_amdgcn_fence(__ATOMIC_ACQUIRE, "agent");
            asm volatile("s_waitcnt vmcnt(0)" ::: "memory");
        }
    }
    __syncthreads();
}


template <int OFF> __device__ __forceinline__ const float* karg_ptr() { const __attribute__((address_space(1))) float* r; asm volatile("s_load_dwordx2 %0, %1, %2\n\ts_waitcnt lgkmcnt(0)" : "=s"(r) : "s"(__builtin_amdgcn_kernarg_segment_ptr()), "n"(OFF) : "memory"); return (const float*)r; }
#define IN(i) (karg_ptr<(i) * 8>())
#define OUTP() ((float*)karg_ptr<34 * 8>())
#define WSP() ((unsigned char*)karg_ptr<35 * 8>())
template <class T> __device__ __forceinline__ T launder_s(T v) { asm volatile("" : "+s"(v)); return v; }
struct Params { const float* in[34]; float* out; unsigned char* ws; };
constexpr size_t MiB = 1ull << 20;
constexpr size_t WL_BYTES = 43 * MiB;
constexpr size_t oWin = 0, oWb = 9175040, oWo = 11272192, oWup = 12320768, oWd = 18087936, oWp = 20971520, oWg = 21233664, oPw = 22282240, oW2 = 22347776, oA2 = 22380544, oG2 = 22413312;
constexpr size_t XB_OFF = 86 * MiB, PB_OFF = 118 * MiB, SS_OFF = 126 * MiB, SAVEA_OFF = 126 * MiB + 256 * 1024, SAVEB_OFF = SAVEA_OFF + 128 * 1024, SAVEU_OFF = SAVEB_OFF + 32 * 1024,
                 C1_OFF = 127 * MiB, C2_OFF = C1_OFF + 512 * 1024, C3_OFF = 128 * MiB, RS_OFF = 129 * MiB, HS_OFF = 130 * MiB, ST_OFF = 132 * MiB;
constexpr size_t BAR_OFF = SS_OFF + 196608;
constexpr int MS = 16384;
struct Bufs {
    bf16_t* W; bf16_t* xb; bf16_t* pb; float* ss0; float* ss1; float* ss2; bf16_t* saveA; bf16_t* saveB; bf16_t* saveU; float* C1; float* C2; float* C3; float* RS; float* HS;
    bf16_t* bufA; bf16_t* bufB; bf16_t* bufC; bf16_t* bufD; float* Wf; bf16_t* KK; bf16_t* V; bf16_t* G; bf16_t* br;
    float* mrg; bf16_t* gates; bf16_t* mb; bf16_t* bufU; bf16_t* act; bf16_t* pp; bf16_t* St; float* DEC;
};
__device__ __forceinline__ Bufs make_bufs(unsigned char* ws, int l) {
    Bufs B; unsigned char* st = ws + ST_OFF;
    B.W = (bf16_t*)(ws + (size_t)l * WL_BYTES); B.xb = (bf16_t*)(ws + XB_OFF); B.pb = (bf16_t*)(ws + PB_OFF);
    B.ss0 = (float*)(ws + SS_OFF); B.ss1 = B.ss0 + MS; B.ss2 = B.ss1 + MS;
    B.saveA = (bf16_t*)(ws + SAVEA_OFF); B.saveB = (bf16_t*)(ws + SAVEB_OFF); B.saveU = (bf16_t*)(ws + SAVEU_OFF);
    B.C1 = (float*)(ws + C1_OFF); B.C2 = (float*)(ws + C2_OFF); B.C3 = (float*)(ws + C3_OFF); B.RS = (float*)(ws + RS_OFF); B.HS = (float*)(ws + HS_OFF);
    B.bufA = (bf16_t*)(st); B.bufB = (bf16_t*)(st + 16 * MiB); B.bufC = (bf16_t*)(st + 72 * MiB); B.bufD = (bf16_t*)(st + 104 * MiB);
    B.Wf = (float*)(st + 152 * MiB); B.KK = (bf16_t*)(st + 184 * MiB)  ; B.V = (bf16_t*)(st + 248 * MiB); B.G = (bf16_t*)(st + 264 * MiB);
    B.br = (bf16_t*)(st + 280 * MiB);
    B.mrg = (float*)(st); B.gates = (bf16_t*)(st + 64 * MiB); B.mb = (bf16_t*)(st + 96 * MiB);
    B.bufU = (bf16_t*)(st); B.act = (bf16_t*)(st + 176 * MiB); B.pp = (bf16_t*)(st + 280 * MiB);
    B.St = (bf16_t*)(st + 344 * MiB); B.DEC = (float*)(st + 376 * MiB);
    return B;
}
constexpr size_t VEC_STRIDE = (size_t)MS * 512;

__device__ __forceinline__ f32x4 mma_tile(const bf16_t* A, int lda, const bf16_t* Bt, int ldb, int K, int lane) {
    f32x4 acc = {0.f, 0.f, 0.f, 0.f};
    const bf16_t* ap = A + (lane & 15) * lda + (lane >> 4) * 8;
    const bf16_t* bp = Bt + (lane & 15) * ldb + (lane >> 4) * 8;
    for (int k = 0; k < K; k += 32) {
        const bf16x8 a = *(const bf16x8*)(ap + k), b = *(const bf16x8*)(bp + k);
        acc = __builtin_amdgcn_mfma_f32_16x16x32_bf16(a, b, acc, 0, 0, 0);
    }
    return acc;
}

template <int NK> __device__ __forceinline__ void load_bfrag(bf16x8 (&f)[NK], const bf16_t* Bt, int ldb, int lane) {
    const bf16_t* bp = Bt + (lane & 15) * ldb + (lane >> 4) * 8;
#pragma unroll
    for (int k = 0; k < NK; ++k) f[k] = *(const bf16x8*)(bp + k * 32);
}
template <int NK> __device__ __forceinline__ f32x4 mma_tile_pre(const bf16_t* A, int lda, const bf16x8 (&f)[NK], int lane) {
    f32x4 acc = {0.f, 0.f, 0.f, 0.f};
    const bf16_t* ap = A + (lane & 15) * lda + (lane >> 4) * 8;
#pragma unroll
    for (int k = 0; k < NK; ++k) acc = __builtin_amdgcn_mfma_f32_16x16x32_bf16(*(const bf16x8*)(ap + k * 32), f[k], acc, 0, 0, 0);
    return acc;
}

template <bool SA, bool SB> __device__ __forceinline__ f32x4 mma_tile64(const bf16_t* A, int ra0, const bf16_t* Bt, int rb0, int lane) {
    f32x4 acc = {0.f, 0.f, 0.f, 0.f};
    const int ra = ra0 + (lane & 15), rb = rb0 + (lane & 15), q = lane >> 4;
    const int sa = SA ? ((ra >> 3) & 7) : 0, sb = SB ? ((rb >> 3) & 7) : 0;
#pragma unroll
    for (int kk = 0; kk < 2; ++kk) {
        const bf16x8 a = *(const bf16x8*)(A + ra * 72 + (((kk * 4 + q) ^ sa) << 3));
        const bf16x8 b = *(const bf16x8*)(Bt + rb * 72 + (((kk * 4 + q) ^ sb) << 3));
        acc = __builtin_amdgcn_mfma_f32_16x16x32_bf16(a, b, acc, 0, 0, 0);
    }
    return acc;
}

__device__ __forceinline__ void tconv(const float* __restrict__ src, bf16_t* __restrict__ dst, int K, int N, const float* __restrict__ scale, float* tile, int& rot) {
    const int tk = K >> 6, tn = N >> 6, nt = tk * tn, G = gridDim.x;
    const int tid = tid_v(), lr = tid >> 4, lc = (tid & 15) * 4;
    const int sn = tid >> 3, sk = (tid & 7) * 8;
    int t = (int)((bid_s() + G - (rot % G)) % G);
    f32x4 v0, v1;
    if (t < nt) { const int kt = t / tn, k0 = kt << 6, n0 = (t - kt * tn) << 6; v0 = *(const f32x4*)(src + (size_t)(k0 + lr) * N + n0 + lc); v1 = *(const f32x4*)(src + (size_t)(k0 + lr + 32) * N + n0 + lc); }
    for (; t < nt; t += G) {
        const int kt = t / tn, k0 = kt << 6, n0 = (t - kt * tn) << 6;
        __syncthreads();
#pragma unroll
        for (int j = 0; j < 4; ++j) { tile[lr * 65 + lc + j] = v0[j]; tile[(lr + 32) * 65 + lc + j] = v1[j]; }
        const int t2 = t + G;
        if (t2 < nt) { const int kt2 = t2 / tn, k2 = kt2 << 6, n2 = (t2 - kt2 * tn) << 6; v0 = *(const f32x4*)(src + (size_t)(k2 + lr) * N + n2 + lc); v1 = *(const f32x4*)(src + (size_t)(k2 + lr + 32) * N + n2 + lc); }
        __syncthreads();
        f32x4 a, bb;
#pragma unroll
        for (int j = 0; j < 4; ++j) { a[j] = tile[(sk + j) * 65 + sn]; bb[j] = tile[(sk + 4 + j) * 65 + sn]; }
        if (scale) { a *= *(const f32x4*)(scale + k0 + sk); bb *= *(const f32x4*)(scale + k0 + sk + 4); }
        *(u32x4*)(dst + (size_t)(n0 + sn) * K + k0 + sk) = pack8(a, bb);
    }
    rot += nt;
}
__device__ __forceinline__ void phase0(unsigned char* shm) {
    float* tile = (float*)shm; int rot = 0;
    for (int l = 0; l < 2; ++l) {
        bf16_t* W = (bf16_t*)(WSP() + (size_t)l * WL_BYTES);
        tconv(IN(3) + (size_t)l * 1024 * 8960, W + oWin, 1024, 8960, IN(2) + l * 1024, tile, rot);
        for (int k = 0; k < 4; ++k) tconv(IN(23) + (size_t)(l * 4 + k) * 512 * 1024, W + oWb + (size_t)k * 1024 * 512, 512, 1024, nullptr, tile, rot);
        tconv(IN(24) + (size_t)l * 1024 * 1024, W + oWo, 1024, 1024, nullptr, tile, rot);
        tconv(IN(26) + (size_t)l * 1024 * 5632, W + oWup, 1024, 5632, IN(25) + l * 1024, tile, rot);
        tconv(IN(29) + (size_t)l * 2816 * 1024, W + oWd, 2816, 1024, nullptr, tile, rot);
        tconv(IN(31) + (size_t)l * 256 * 1024, W + oWp, 256, 1024, nullptr, tile, rot);
        tconv(IN(32) + (size_t)l * 1024 * 1024, W + oWg, 1024, 1024, IN(30) + l * 1024, tile, rot);
        for (int g = 0; g < 4; ++g) tconv(IN(4) + (size_t)(l * 4 + g) * 128 * 128, W + oPw + (size_t)g * 16384, 128, 128, nullptr, tile, rot);
        tconv(IN(8) + (size_t)l * 64 * 512, W + oW2, 64, 512, nullptr, tile, rot);
        tconv(IN(10) + (size_t)l * 64 * 512, W + oA2, 64, 512, nullptr, tile, rot);
        tconv(IN(11) + (size_t)l * 128 * 512, W + oG2, 128, 512, nullptr, tile, rot);
    }
    __syncthreads();
}

__device__ __forceinline__ void phaseX(int l, int s) {
    const Bufs B = make_bufs(WSP(), l);
    const float* xin = l == 0 ? IN(0) : OUTP();
    const float* pin = IN(1) + (size_t)l * 32768 * 256;
    const int lane = tid_v() & 63, gw = bid_s() * 8 + (tid_v() >> 6);
    for (int mb = gw; mb < MS; mb += 4096) {
        f32x4 v[2][4], pv[2]; size_t rg[2];
#pragma unroll
        for (int u = 0; u < 2; ++u) { const int m = mb + 2048 * u; rg[u] = (size_t)((m >> 11) * 4096 + s * 2048 + (m & 2047)); const f32x4* xr = (const f32x4*)(xin + rg[u] * 1024);
#pragma unroll
            for (int i = 0; i < 4; ++i) v[u][i] = xr[lane + 64 * i];
            pv[u] = *(const f32x4*)(pin + rg[u] * 256 + lane * 4); }
#pragma unroll
        for (int u = 0; u < 2; ++u) { const int m = mb + 2048 * u; float sum = 0.f;
#pragma unroll
            for (int i = 0; i < 4; ++i) { const f32x4 x = v[u][i]; sum += x[0] * x[0] + x[1] * x[1] + x[2] * x[2] + x[3] * x[3]; }
            sum = wsum(sum);
            const float rs = rsqrtf(sum * (1.0f / 1024.0f) + 1e-6f);
#pragma unroll
            for (int i = 0; i < 4; ++i) { const f32x4 x = v[u][i] * rs;
                u32x2 w; w.x = cvt_pk_bf16(x[0], x[1]); w.y = cvt_pk_bf16(x[2], x[3]); *(u32x2*)(B.xb + (size_t)m * 1024 + (lane + 64 * i) * 4) = w; }
            if (lane == 0) { B.ss1[m] = 0.f; B.ss2[m] = 0.f; }
            u32x2 w; w.x = cvt_pk_bf16(pv[u][0], pv[u][1]); w.y = cvt_pk_bf16(pv[u][2], pv[u][3]); *(u32x2*)(B.pb + (size_t)m * 256 + lane * 4) = w; }
    }
}

struct PoolRegs { u32x4 rv[3]; };
__device__ __forceinline__ PoolRegs pool_issue(const Bufs& B, int s, int it, int tid) {
    PoolRegs R; const int tt = it >> 2, g = it & 3, m0 = tt * 64, b = m0 >> 11, tl0 = m0 & 2047;
#pragma unroll
    for (int i = 0; i < 3; ++i) {
        int idx = tid + 512 * i; idx = idx < 1280 ? idx : 1279;
        const int r = idx >> 4, c8 = (idx & 15) * 8, tl = tl0 - 16 + r;
        const bf16_t* src = tl >= 0 ? B.bufA + (size_t)(b * 2048 + tl) * 512 + g * 128 + c8 : B.saveA + (size_t)(b * 16 + 16 + tl) * 512 + g * 128 + c8;
        R.rv[i] = *(const u32x4*)src;
        if (tl < 0 && s == 0) R.rv[i] = (u32x4){0u, 0u, 0u, 0u};
    }
    return R;
}
__device__ __forceinline__ void pool_item(const Bufs& B, int l, int s, int it, unsigned char* shm, const PoolRegs& R) {
    const int tid = tid_v(), lane = tid & 63, wid = tid >> 6;
    const int tt = it >> 2, g = it & 3, m0 = tt * 64, b = m0 >> 11, tl0 = m0 & 2047;
    float* raw = (float*)shm;
    bf16_t* dA = (bf16_t*)(shm + 40960);
    bf16x8 pf[4]; load_bfrag<4>(pf, B.W + oPw + (size_t)g * 16384 + wid * 16 * 128, 128, lane);
    __syncthreads();
#pragma unroll
    for (int i = 0; i < 3; ++i) {
        const int idx = tid + 512 * i;
        if (idx < 1280) {
            const int r = idx >> 4, c8 = (idx & 15) * 8, tl = tl0 - 16 + r;
            f32x4 a, bb; unpack8(R.rv[i], a, bb);
            *(f32x4*)(raw + r * 128 + c8) = a; *(f32x4*)(raw + r * 128 + c8 + 4) = bb;
            if (s == 0 && tl >= 2032) *(u32x4*)(B.saveA + (size_t)(b * 16 + tl - 2032) * 512 + g * 128 + c8) = R.rv[i];
        }
    }
    __syncthreads();
    {
        const int win = 2 << g, c = tid & 127, t0 = (tid >> 7) * 16;
        float run = 0.f;
        for (int j = 1; j < win; ++j) run += raw[(16 + t0 - j) * 128 + c];
#pragma unroll 4
        for (int q = 0; q < 16; ++q) {
            const int t = t0 + q, tg = s * 2048 + tl0 + t;
            const float cur = raw[(16 + t) * 128 + c];
            run += cur;
            const int cnt = (tg + 1) < win ? (tg + 1) : win;
            dA[t * 136 + c] = f2bf(run / (float)cnt - cur);
            run -= raw[(16 + t - win + 1) * 128 + c];
        }
    }
    __syncthreads();
    const float* scale = IN(5) + l * 512 + g * 128;
    for (int tile = wid; tile < 32; tile += 8) {
        const int tm = tile >> 3, tn = tile & 7;
        const f32x4 acc = mma_tile_pre<4>(dA + tm * 16 * 136, 136, pf, lane);
        const int col = tn * 16 + (lane & 15);
        const float sc = scale[col];
#pragma unroll
        for (int j = 0; j < 4; ++j) { const int row = tm * 16 + (lane >> 4) * 4 + j; B.br[(size_t)(m0 + row) * 512 + g * 128 + col] = f2bf(acc[j] * sc); }
    }
}

__device__ __forceinline__ void sg_item(const Bufs& B, int l, int s, int it, unsigned char* shm) {
    const int tid = tid_v(), lane = tid & 63, wid = tid >> 6;
    const int ch = it >> 2, g = it & 3, m0 = ch * 128;
    bf16_t* Wm = (bf16_t*)shm;
    bf16_t* VnT = (bf16_t*)(shm + 34816);
    bf16_t* uS = (bf16_t*)(shm + 69632);
    const int t = tid >> 2, part = tid & 3, cl0 = part * 32, cg0 = g * 128 + cl0;
    u32x4 sv[16], vq[4], uv[4]; f32x4 wv[8];
    {
        const u32x4* vp = (const u32x4*)(B.bufC + (size_t)(m0 + t) * 1024 + 512 + part * 128);
#pragma unroll
        for (int i = 0; i < 16; ++i) sv[i] = vp[i];
        const u32x4* vqp = (const u32x4*)(B.bufC + (size_t)(m0 + t) * 1024 + 512 + cg0);
#pragma unroll
        for (int i = 0; i < 4; ++i) vq[i] = vqp[i];
        const float* sw = IN(19) + (size_t)(l * 4 + g) * 16384;
#pragma unroll
        for (int i = 0; i < 8; ++i) wv[i] = *(const f32x4*)(sw + (tid + 512 * i) * 4);
    }
    __syncthreads();
    {
        float sum = 0.f, sq = 0.f;
#pragma unroll
        for (int i = 0; i < 16; ++i) { f32x4 a, bb; unpack8(sv[i], a, bb);
            sum += (a[0] + a[1]) + (a[2] + a[3]) + (bb[0] + bb[1]) + (bb[2] + bb[3]);
            sq += a[0] * a[0] + a[1] * a[1] + a[2] * a[2] + a[3] * a[3] + bb[0] * bb[0] + bb[1] * bb[1] + bb[2] * bb[2] + bb[3] * bb[3]; }
        sum += __shfl_xor(sum, 1); sum += __shfl_xor(sum, 2); sq += __shfl_xor(sq, 1); sq += __shfl_xor(sq, 2);
        const float mean = sum * (1.0f / 512.0f), var = sq * (1.0f / 512.0f) - mean * mean, rstd = rsqrtf(fmaxf(var, 0.f) + 1e-5f);
#pragma unroll
        for (int i = 0; i < 4; ++i) { const int idx = tid + 512 * i; uv[i] = *(const u32x4*)(B.bufC + (size_t)(m0 + (idx >> 4)) * 1024 + g * 128 + (idx & 15) * 8); }
        const float* lnw = IN(17) + l * 512 + cg0; const float* lnb = IN(18) + l * 512 + cg0;
#pragma unroll
        for (int i = 0; i < 4; ++i) { f32x4 a, bb; unpack8(vq[i], a, bb);
#pragma unroll
            for (int j = 0; j < 4; ++j) {
                VnT[(cl0 + i * 8 + j) * 136 + t] = f2bf((a[j] - mean) * rstd * lnw[i * 8 + j] + lnb[i * 8 + j]);
                VnT[(cl0 + i * 8 + 4 + j) * 136 + t] = f2bf((bb[j] - mean) * rstd * lnw[i * 8 + 4 + j] + lnb[i * 8 + 4 + j]); } }
#pragma unroll
        for (int i = 0; i < 8; ++i) { const int idx = tid + 512 * i, tt = idx >> 5, s4 = (idx & 31) * 4;
            u32x2 w; w.x = cvt_pk_bf16(s4 <= tt ? wv[i][0] : 0.f, s4 + 1 <= tt ? wv[i][1] : 0.f); w.y = cvt_pk_bf16(s4 + 2 <= tt ? wv[i][2] : 0.f, s4 + 3 <= tt ? wv[i][3] : 0.f);
            *(u32x2*)(Wm + tt * 136 + s4) = w; }
#pragma unroll
        for (int i = 0; i < 4; ++i) { const int idx = tid + 512 * i; *(u32x4*)(uS + (idx >> 4) * 136 + (idx & 15) * 8) = uv[i]; }
    }
    __syncthreads();
    const float* sb = IN(20) + (l * 4 + g) * 128;
    for (int tile = wid; tile < 64; tile += 8) {
        const int tm = tile >> 3, tn = tile & 7;
        const int Kc = ((tm * 16 + 16 + 31) >> 5) << 5;
        const f32x4 acc = mma_tile(Wm + tm * 16 * 136, 136, VnT + tn * 16 * 136, 136, Kc, lane);
        const int c = tn * 16 + (lane & 15);
#pragma unroll
        for (int j = 0; j < 4; ++j) { const int tq = tm * 16 + (lane >> 4) * 4 + j;
            B.br[2 * VEC_STRIDE + (size_t)(m0 + tq) * 512 + g * 128 + c] = f2bf(bf2f(uS[tq * 136 + c]) * (acc[j] + sb[tq])); }
    }
}

__device__ __forceinline__ float rsum8(float v) { v += dppf<0xB1>(v); v += dppf<0x4E>(v); v += dppf<0x141>(v); return v; }
struct PrepRegs { u32x4 cw, pw; };
__device__ __forceinline__ PrepRegs prep_issue(const Bufs& B, int s, int it, int tid) {
    PrepRegs R; const int m0 = it * 16, b = m0 >> 11, tl0 = m0 & 2047;
    const bf16_t* sB = B.saveB + b * 1792; const u32x4 zero4 = {0u, 0u, 0u, 0u};
    { const int t = tid >> 5, cg = tid & 31, c0 = 1536 + cg * 8, m = m0 + t, tl = tl0 + t;
      R.cw = *(const u32x4*)(B.bufB + (size_t)m * 1792 + c0);
      R.pw = tl > 0 ? *(const u32x4*)(B.bufB + (size_t)(m - 1) * 1792 + c0) : (s == 1 ? *(const u32x4*)(sB + c0) : zero4); }
    return R;
}
__device__ __forceinline__ void prep_item(const Bufs& B, int l, int s, int it, unsigned char* shm, const bf16x8 (&w2f)[4][2], const bf16x8 (&a2f)[4][2], const PrepRegs& R) {
    const int tid = tid_v(), lane = tid & 63, wid = tid >> 6;
    const int m0 = it * 16, b = m0 >> 11, tl0 = m0 & 2047;
    bf16_t* Lw = (bf16_t*)shm;
    bf16_t* La = (bf16_t*)(shm + 2304);
    bf16_t* Lg = (bf16_t*)(shm + 4608);
    float* Aa = (float*)(shm + 9216);
    float* Dd = (float*)(shm + 9216 + 32768);
    const float* mu = IN(6) + l * 1792;
    const bf16_t* sB = B.saveB + b * 1792;
    const u32x4 zero4 = {0u, 0u, 0u, 0u};
    u32x4 c3w[2][3], p3w[2][3];
#pragma unroll
    for (int tt = 0; tt < 2; ++tt) { const int t = wid + 8 * tt, m = m0 + t, tl = tl0 + t; const bf16_t* cr = B.bufB + (size_t)m * 1792 + lane * 8;
#pragma unroll
        for (int q = 0; q < 3; ++q) { c3w[tt][q] = *(const u32x4*)(cr + q * 512); p3w[tt][q] = tl > 0 ? *(const u32x4*)(cr - 1792 + q * 512) : (s == 1 ? *(const u32x4*)(sB + q * 512 + lane * 8) : zero4); } }
    __syncthreads();
    {
        const int t = tid >> 5, cg = tid & 31, c0 = 1536 + cg * 8;
        f32x4 c0v, c1v, p0v, p1v; unpack8(R.cw, c0v, c1v); unpack8(R.pw, p0v, p1v);
        const f32x4 m0v = *(const f32x4*)(mu + c0), m1v = *(const f32x4*)(mu + c0 + 4);
        f32x4 x0 = c0v + m0v * (p0v - c0v), x1 = c1v + m1v * (p1v - c1v);
        if (cg < 8) {
#pragma unroll
            for (int j = 0; j < 4; ++j) { x0[j] = 2.0f * sigm(2.0f * x0[j]) - 1.0f; x1[j] = 2.0f * sigm(2.0f * x1[j]) - 1.0f; }
            *(u32x4*)(Lw + t * 72 + cg * 8) = pack8(x0, x1);
        } else if (cg < 16) {
            *(u32x4*)(La + t * 72 + (cg - 8) * 8) = pack8(x0, x1);
        } else {
#pragma unroll
            for (int j = 0; j < 4; ++j) { x0[j] = sigm(x0[j]); x1[j] = sigm(x1[j]); }
            *(u32x4*)(Lg + t * 136 + (cg - 16) * 8) = pack8(x0, x1);
        }
    }
    __syncthreads();
    {
        const float* w0 = IN(7) + l * 512; const float* a0 = IN(9) + l * 512;
#pragma unroll
        for (int i = 0; i < 4; ++i) {
            const int tn = wid + 8 * i, c = tn * 16 + (lane & 15);
            bf16x8 g2f[4]; load_bfrag<4>(g2f, B.W + oG2 + tn * 16 * 128, 128, lane);
            f32x4 acc = mma_tile_pre<2>(Lw, 72, w2f[i], lane);
#pragma unroll
            for (int j = 0; j < 4; ++j) { const int t = (lane >> 4) * 4 + j; Dd[t * 512 + c] = __expf(-0.6065306597f * sigm(w0[c] + acc[j])); }
            acc = mma_tile_pre<2>(La, 72, a2f[i], lane);
#pragma unroll
            for (int j = 0; j < 4; ++j) { const int t = (lane >> 4) * 4 + j; Aa[t * 512 + c] = sigm(a0[c] + acc[j]); }
            acc = mma_tile_pre<4>(Lg, 136, g2f, lane);
#pragma unroll
            for (int j = 0; j < 4; ++j) { const int t = (lane >> 4) * 4 + j; B.G[(size_t)(m0 + t) * 512 + c] = f2bf(acc[j]); }
        }
    }
    __syncthreads();
    const float* kkp = IN(12) + l * 512; const float* kap = IN(13) + l * 512; const float* rkp = IN(14) + l * 512;
    const int c0 = lane * 8, h = lane >> 3;
#pragma unroll
    for (int tt = 0; tt < 2; ++tt) {
        const int t = wid + 8 * tt, m = m0 + t, tl = tl0 + t;
        const bf16_t* cr = B.bufB + (size_t)m * 1792;
        f32x4 r[2], k[2], v[2];
#pragma unroll
        for (int q = 0; q < 3; ++q) {
            f32x4 c0v, c1v, p0v, p1v; unpack8(c3w[tt][q], c0v, c1v); unpack8(p3w[tt][q], p0v, p1v);
            const f32x4 m0v = *(const f32x4*)(mu + q * 512 + c0), m1v = *(const f32x4*)(mu + q * 512 + c0 + 4);
            const f32x4 x0 = c0v + m0v * (p0v - c0v), x1 = c1v + m1v * (p1v - c1v);
            if (q == 0) { r[0] = x0; r[1] = x1; } else if (q == 1) { k[0] = x0; k[1] = x1; } else { v[0] = x0; v[1] = x1; }
        }
        f32x4 kk[2], kp[2], ka[2], wv[2], av[2];
        float n2 = 0.f, c2 = 0.f, c3 = 0.f;
#pragma unroll
        for (int e = 0; e < 2; ++e) {
            av[e] = *(const f32x4*)(Aa + t * 512 + c0 + 4 * e); wv[e] = *(const f32x4*)(Dd + t * 512 + c0 + 4 * e);
            const f32x4 kkw = *(const f32x4*)(kkp + c0 + 4 * e), kaw = *(const f32x4*)(kap + c0 + 4 * e), rkw = *(const f32x4*)(rkp + c0 + 4 * e);
            kk[e] = k[e] * kkw;
            kp[e] = k[e] * (1.0f + (av[e] - 1.0f) * kaw);
#pragma unroll
            for (int j = 0; j < 4; ++j) { n2 += kk[e][j] * kk[e][j]; c2 += kp[e][j] * r[e][j]; c3 += r[e][j] * kp[e][j] * rkw[j]; }
        }
        n2 = rsum8(n2); c2 = rsum8(c2); c3 = rsum8(c3);
        const float inv = 1.0f / fmaxf(sqrtf(n2), 1e-12f);
        float c1 = 0.f;
#pragma unroll
        for (int e = 0; e < 2; ++e) { kk[e] = kk[e] * inv; ka[e] = kk[e] * av[e];
#pragma unroll
            for (int j = 0; j < 4; ++j) c1 += ka[e][j] * r[e][j]; }
        c1 = rsum8(c1);
        const size_t o = (size_t)m * 512 + c0;
        *(f32x4*)(B.Wf + o) = wv[0]; *(f32x4*)(B.Wf + o + 4) = wv[1];
        *(u32x4*)(B.KK + o) = pack8(kk[0], kk[1]);
        *(u32x4*)(B.KK + VEC_STRIDE + o) = pack8(wv[0] * r[0], wv[1] * r[1]);
        *(u32x4*)(B.KK + 2 * VEC_STRIDE + o) = pack8(ka[0], ka[1]);
        *(u32x4*)(B.KK + 3 * VEC_STRIDE + o) = pack8(kp[0], kp[1]);
        *(u32x4*)(B.V + o) = pack8(v[0], v[1]);
        if ((lane & 7) == 0) { B.C1[m * 8 + h] = c1; B.C2[m * 8 + h] = c2; B.C3[m * 8 + h] = c3; }
    }
    if (s == 0 && tl0 + 16 == 2048) for (int c = tid; c < 1792; c += 512) B.saveB[b * 1792 + c] = B.bufB[(size_t)(b * 2048 + 2047) * 1792 + c];
}

__device__ __forceinline__ void hg_cum(const u32x4 (&ev)[2], int l, int h, const float* hlb, float* cumS, float* lbS, int tid) {
    __syncthreads();
    if (tid < 128) lbS[tid] = l == 0 ? 1.0f : 1.0f - sigm(hlb[512 + h * 128 + tid] - hlb[h * 128 + tid]);
    __syncthreads();
#pragma unroll
    for (int q = 0; q < 2; ++q) {
        const int idx = tid + 512 * q, t = idx >> 4, k8 = (idx & 15) * 8;
        f32x4 a, bb; unpack8(ev[q], a, bb);
        const f32x4 l0 = *(const f32x4*)(lbS + k8), l1 = *(const f32x4*)(lbS + k8 + 4);
#pragma unroll
        for (int j = 0; j < 4; ++j) { a[j] = __logf(fmaxf(1.0f - l0[j] * a[j], 1e-30f)); bb[j] = __logf(fmaxf(1.0f - l1[j] * bb[j], 1e-30f)); }
        *(f32x4*)(cumS + t * 128 + k8) = a; *(f32x4*)(cumS + t * 128 + k8 + 4) = bb;
    }
    __syncthreads();
    const int k = tid & 127, seg = tid >> 7;
    { float run = 0.f;
#pragma unroll
      for (int tt = 0; tt < 16; ++tt) { const int t = seg * 16 + tt; run += cumS[t * 128 + k]; cumS[t * 128 + k] = run; } }
    __syncthreads();
    float off = 0.f;
    for (int sp = 0; sp < seg; ++sp) off += cumS[(16 * sp + 15) * 128 + k];
    __syncthreads();
#pragma unroll
    for (int tt = 0; tt < 16; ++tt) cumS[(seg * 16 + tt) * 128 + k] += off;
    __syncthreads();
}

struct HgRegs { u32x4 ev[2], iv[2]; };
__device__ __forceinline__ HgRegs hgA_issue(const Bufs& B, int it, int tid) {
    HgRegs R; const int bh = it >> 5, ch = it & 31, b = bh >> 2, h = bh & 3, m0 = b * 2048 + ch * 64;
#pragma unroll
    for (int q = 0; q < 2; ++q) { const int idx = tid + 512 * q; const bf16_t* rowp = B.bufD + (size_t)(m0 + (idx >> 4)) * 1536 + h * 128 + (idx & 15) * 8; R.ev[q] = *(const u32x4*)(rowp + 512); R.iv[q] = *(const u32x4*)(rowp + 1024); }
    return R;
}
__device__ __forceinline__ void hgA_item(const Bufs& B, int l, int it, unsigned char* shm, const float* hlb, const HgRegs& R) {
    const int tid = tid_v(), lane = tid & 63, wid = tid >> 6;
    const int bh = it >> 5, ch = it & 31, b = bh >> 2, h = bh & 3, m0 = b * 2048 + ch * 64;
    float* cumS = (float*)shm;
    bf16_t* kdT = (bf16_t*)(shm + 32768);
    bf16_t* iT = (bf16_t*)(shm + 32768 + 18432);
    float* lbS = (float*)(shm + 32768 + 36864);
    hg_cum(R.ev, l, h, hlb, cumS, lbS, tid);
#pragma unroll
    for (int q = 0; q < 2; ++q) {
        const int idx = tid + 512 * q, t = idx >> 4, k8 = (idx & 15) * 8;
        f32x4 a, bb; unpack8(R.ev[q], a, bb);
        const u32x4 iw = R.iv[q];
        const int tx = t ^ (((k8 >> 3) & 7) << 3);
#pragma unroll
        for (int j = 0; j < 4; ++j) {
            kdT[(k8 + j) * 72 + tx] = f2bf(lbS[k8 + j] * a[j] * __expf(cumS[63 * 128 + k8 + j] - cumS[t * 128 + k8 + j]));
            kdT[(k8 + 4 + j) * 72 + tx] = f2bf(lbS[k8 + 4 + j] * bb[j] * __expf(cumS[63 * 128 + k8 + 4 + j] - cumS[t * 128 + k8 + 4 + j]));
        }
        iT[(k8 + 0) * 72 + tx] = (bf16_t)(iw.x & 0xffffu); iT[(k8 + 1) * 72 + tx] = (bf16_t)(iw.x >> 16); iT[(k8 + 2) * 72 + tx] = (bf16_t)(iw.y & 0xffffu); iT[(k8 + 3) * 72 + tx] = (bf16_t)(iw.y >> 16);
        iT[(k8 + 4) * 72 + tx] = (bf16_t)(iw.z & 0xffffu); iT[(k8 + 5) * 72 + tx] = (bf16_t)(iw.z >> 16); iT[(k8 + 6) * 72 + tx] = (bf16_t)(iw.w & 0xffffu); iT[(k8 + 7) * 72 + tx] = (bf16_t)(iw.w >> 16);
    }
    if (tid < 128) B.DEC[it * 128 + tid] = __expf(cumS[63 * 128 + tid]);
    __syncthreads();
    bf16_t* Sg = B.St + (size_t)it * 16384;
    for (int tile = wid; tile < 64; tile += 8) {
        const int tm = tile >> 3, tn = tile & 7;
        const f32x4 acc = mma_tile64<true, true>(iT, tm * 16, kdT, tn * 16, lane);
#pragma unroll
        for (int j = 0; j < 4; ++j) Sg[(tm * 16 + (lane >> 4) * 4 + j) * 128 + tn * 16 + (lane & 15)] = f2bf(acc[j]);
    }
}

__device__ __forceinline__ void hgC_item(const Bufs& B, int l, int it, unsigned char* shm, const float* hlb, const float* hn) {
    const int tid = tid_v(), lane = tid & 63, wid = tid >> 6;
    const int bh = it >> 5, ch = it & 31, b = bh >> 2, h = bh & 3, m0 = b * 2048 + ch * 64;
    float* cumS = (float*)shm;
    bf16_t* qe = (bf16_t*)(shm + 33792);
    bf16_t* qa = (bf16_t*)(shm + 51200);
    bf16_t* kb = (bf16_t*)(shm + 68608);
    bf16_t* iT = (bf16_t*)(shm + 86016);
    bf16_t* P = (bf16_t*)(shm + 104448);
    float* lbS = (float*)(shm + 113664);
    bf16x8 sf[4]; load_bfrag<4>(sf, B.St + (size_t)it * 16384 + wid * 16 * 128, 128, lane);
    u32x4 ev[2], iv[2], qv[2];
#pragma unroll
    for (int q = 0; q < 2; ++q) { const int idx = tid + 512 * q; const bf16_t* rowp = B.bufD + (size_t)(m0 + (idx >> 4)) * 1536 + h * 128 + (idx & 15) * 8; qv[q] = *(const u32x4*)rowp; ev[q] = *(const u32x4*)(rowp + 512); iv[q] = *(const u32x4*)(rowp + 1024); }
    hg_cum(ev, l, h, hlb, cumS, lbS, tid);
#pragma unroll
    for (int q = 0; q < 2; ++q) {
        const int idx = tid + 512 * q, t = idx >> 4, k8 = (idx & 15) * 8;
        f32x4 q0, q1, e0, e1; unpack8(qv[q], q0, q1); unpack8(ev[q], e0, e1);
        const u32x4 iw = iv[q];
        const int tx = t ^ (((k8 >> 3) & 7) << 3);
        const f32x4 c0 = *(const f32x4*)(cumS + t * 128 + k8), c1 = *(const f32x4*)(cumS + t * 128 + k8 + 4), m0v = *(const f32x4*)(cumS + 31 * 128 + k8), m1v = *(const f32x4*)(cumS + 31 * 128 + k8 + 4);
        const f32x4 l0 = *(const f32x4*)(lbS + k8), l1 = *(const f32x4*)(lbS + k8 + 4);
        f32x4 x0, x1, y0, y1, z0, z1;
#pragma unroll
        for (int j = 0; j < 4; ++j) {
            x0[j] = q0[j] * __expf(c0[j]); x1[j] = q1[j] * __expf(c1[j]);
            y0[j] = q0[j] * __expf(fminf(c0[j] - m0v[j], 80.f)); y1[j] = q1[j] * __expf(fminf(c1[j] - m1v[j], 80.f));
            z0[j] = l0[j] * e0[j] * __expf(fminf(m0v[j] - c0[j], 80.f)); z1[j] = l1[j] * e1[j] * __expf(fminf(m1v[j] - c1[j], 80.f));
        }
        *(u32x4*)(qe + t * 136 + k8) = pack8(x0, x1); *(u32x4*)(qa + t * 136 + k8) = pack8(y0, y1); *(u32x4*)(kb + t * 136 + k8) = pack8(z0, z1);
        iT[(k8 + 0) * 72 + tx] = (bf16_t)(iw.x & 0xffffu); iT[(k8 + 1) * 72 + tx] = (bf16_t)(iw.x >> 16); iT[(k8 + 2) * 72 + tx] = (bf16_t)(iw.y & 0xffffu); iT[(k8 + 3) * 72 + tx] = (bf16_t)(iw.y >> 16);
        iT[(k8 + 4) * 72 + tx] = (bf16_t)(iw.z & 0xffffu); iT[(k8 + 5) * 72 + tx] = (bf16_t)(iw.z >> 16); iT[(k8 + 6) * 72 + tx] = (bf16_t)(iw.w & 0xffffu); iT[(k8 + 7) * 72 + tx] = (bf16_t)(iw.w >> 16);
    }
    __syncthreads();
    for (int tile = wid; tile < 16; tile += 8) {
        const int tm = tile >> 2, tn = tile & 3;
        f32x4 acc = {0.f, 0.f, 0.f, 0.f};
        if (tn <= tm) acc = mma_tile(qa + tm * 16 * 136, 136, kb + tn * 16 * 136, 136, 128, lane);
        const int sc = tn * 16 + (lane & 15);
#pragma unroll
        for (int j = 0; j < 4; ++j) { const int t = tm * 16 + (lane >> 4) * 4 + j; P[t * 72 + sc] = f2bf(sc <= t ? acc[j] : 0.f); }
    }
    __syncthreads();
    float* oS = cumS;
    for (int tile = wid; tile < 32; tile += 8) {
        const int tm = tile >> 3, tn = tile & 7;
        const f32x4 acc = mma_tile_pre<4>(qe + tm * 16 * 136, 136, sf, lane) + mma_tile64<false, true>(P, tm * 16, iT, tn * 16, lane);
#pragma unroll
        for (int j = 0; j < 4; ++j) oS[(tm * 16 + (lane >> 4) * 4 + j) * 132 + tn * 16 + (lane & 15)] = acc[j];
    }
    __syncthreads();
#pragma unroll
    for (int q = 0; q < 2; ++q) {
        const int idx = tid + 512 * q, t = idx >> 4, v8 = (idx & 15) * 8;
        f32x4 o0 = *(const f32x4*)(oS + t * 132 + v8), o1 = *(const f32x4*)(oS + t * 132 + v8 + 4);
        float ssq = o0[0] * o0[0] + o0[1] * o0[1] + o0[2] * o0[2] + o0[3] * o0[3] + o1[0] * o1[0] + o1[1] * o1[1] + o1[2] * o1[2] + o1[3] * o1[3];
        ssq = rsum16(ssq);
        const float rs = rsqrtf(ssq * (1.0f / 128.0f) + 1e-6f);
        const f32x4 n0 = *(const f32x4*)(hn + h * 128 + v8), n1 = *(const f32x4*)(hn + h * 128 + v8 + 4);
        *(u32x4*)(B.br + 3 * VEC_STRIDE + (size_t)(m0 + t) * 512 + h * 128 + v8) = pack8(o0 * rs * n0, o1 * rs * n1);
    }
}

__device__ __forceinline__ void phase2(int l, int s, unsigned char* shm) {
    const Bufs B = make_bufs(WSP(), l);
    const float* hlb = IN(21);
    {
        const int lane = tid_v() & 63, wid = tid_v() >> 6;
        bf16x8 w2f[4][2], a2f[4][2];
#pragma unroll
        for (int i = 0; i < 4; ++i) { const int tn = wid + 8 * i; load_bfrag<2>(w2f[i], B.W + oW2 + tn * 16 * 64, 64, lane); load_bfrag<2>(a2f[i], B.W + oA2 + tn * 16 * 64, 64, lane); }
        const int tid = tid_v(), G = (int)gridDim.x; int it = bid_s();
        PrepRegs R = prep_issue(B, s, it, tid);
        for (; it < 1024; it += G) { const PrepRegs N = prep_issue(B, s, it + G < 1024 ? it + G : it, tid); prep_item(B, l, s, it, shm, w2f, a2f, R); R = N; }
    }
    {
        const int tid = tid_v(), G = (int)gridDim.x; int it = bid_s();
        HgRegs R = hgA_issue(B, it, tid);
        for (; it < 1024; it += G) { const HgRegs N = hgA_issue(B, it + G < 1024 ? it + G : it, tid); hgA_item(B, l, it, shm, hlb, R); R = N; }
    }
    for (int it = bid_s(); it < 512; it += gridDim.x) sg_item(B, l, s, it, shm);
    {
        const int tid = tid_v(), G = (int)gridDim.x; int it = bid_s();
        PoolRegs R = pool_issue(B, s, it, tid);
        for (; it < 1024; it += G) { const PoolRegs N = pool_issue(B, s, it + G < 1024 ? it + G : it, tid); pool_item(B, l, s, it, shm, R); R = N; }
    }
}
__device__ __forceinline__ void scans(int l, int s, unsigned char* shm) {
    const Bufs B = make_bufs(WSP(), l);
    constexpr int CS = 16, NCH = 2048 / CS, RST = 340;
    const int tid = tid_v(), lane = tid & 63, wid = tid >> 6;
    const int c = bid_s(), xcd = c & 7, jj = c >> 3;
    const int bhr = xcd * 8 + (jj >> 2), b_r = bhr >> 3, h_r = bhr & 7, rbase = (jj & 3) * 16;
    float* rbuf = (float*)shm;
    float* yl = (float*)(shm + 2 * CS * RST * 4);
    bf16_t* Y = B.br + VEC_STRIDE;
    __syncthreads();
    if (wid < 4) {
        const int loc = wid * 4 + (lane >> 4), col4 = (lane & 15) * 4;
        float* RSp = B.RS + ((size_t)bhr * 64 + rbase + loc) * 64 + col4;
        f32x2 S0 = {0.f, 0.f}, S1 = {0.f, 0.f};
        if (s == 1) { const f32x4 t = *(const f32x4*)RSp; S0 = t.xy; S1 = t.zw; }
        asm volatile("" : "+v"(S0), "+v"(S1));
        __syncthreads();
#pragma unroll 1
        for (int cidx = 0; cidx < NCH; ++cidx) {
            if (cidx > 0) { const int st = tid >> 4, r = tid & 15; Y[(size_t)(b_r * 2048 + (cidx - 1) * CS + st) * 512 + h_r * 64 + rbase + r] = f2bf(yl[((cidx - 1) & 1) * (CS * 16) + tid]); }
            const float* bp = rbuf + (cidx & 1) * (CS * RST); float* ylw = yl + (cidx & 1) * (CS * 16);
            const unsigned ab = (unsigned)(size_t)(PG8_LAS const float*)bp;
            const unsigned a_col = ab + col4 * 4, a_row = ab + 1280 + loc * 4, a_cc = ab + 1344;
            f32x4 Aw4, Akk4, Awr4, Aka4, Akp4, Bw4, Bkk4, Bwr4, Bka4, Bkp4; float Av, Bv; f32x2 Acc, Bcc;
            float ykeep = 0.f;
#define RW_LOAD(P, ST) do { \
                asm volatile("ds_read_b128 %0, %1 offset:%2" : "=v"(P##w4) : "v"(a_col), "n"((ST) * 1360)); \
                asm volatile("ds_read_b128 %0, %1 offset:%2" : "=v"(P##kk4) : "v"(a_col), "n"((ST) * 1360 + 256)); \
                asm volatile("ds_read_b128 %0, %1 offset:%2" : "=v"(P##wr4) : "v"(a_col), "n"((ST) * 1360 + 512)); \
                asm volatile("ds_read_b128 %0, %1 offset:%2" : "=v"(P##ka4) : "v"(a_col), "n"((ST) * 1360 + 768)); \
                asm volatile("ds_read_b128 %0, %1 offset:%2" : "=v"(P##kp4) : "v"(a_col), "n"((ST) * 1360 + 1024)); \
                asm volatile("ds_read_b32 %0, %1 offset:%2" : "=v"(P##v) : "v"(a_row), "n"((ST) * 1360)); \
                asm volatile("ds_read_b64 %0, %1 offset:%2" : "=v"(P##cc) : "v"(a_cc), "n"((ST) * 1360)); } while (0)
#define RW_WAIT(P, N) asm volatile("s_waitcnt lgkmcnt(" #N ")" : "+v"(P##w4), "+v"(P##kk4), "+v"(P##wr4), "+v"(P##ka4), "+v"(P##kp4), "+v"(P##v), "+v"(P##cc))
#define RW_STEP(P, ST) do { \
                f32x2 t = S0 * P##kk4.xy; t = S1 * P##kk4.zw + t; \
                f32x2 u = S0 * P##wr4.xy; u = S1 * P##wr4.zw + u; \
                const f32x2 vv = {P##v, P##v}; \
                const f32x2 Ta = S0 * P##w4.xy + vv * P##kp4.xy, Tb = S1 * P##w4.zw + vv * P##kp4.zw; \
                float pd = t.x + t.y, yq = u.x + u.y; \
                pd = rsum16(pd); yq = rsum16(yq); \
                const float sa = -pd; const f32x2 sa2 = {sa, sa}; \
                S0 = Ta + sa2 * P##ka4.xy; S1 = Tb + sa2 * P##ka4.zw; \
                const float y = yq + sa * P##cc.x + P##v * P##cc.y; \
                ykeep = (lane & 15) == (ST) ? y : ykeep; } while (0)
#define RW_PAIR(ST) do { RW_LOAD(B, (ST) + 1); RW_WAIT(A, 7); RW_STEP(A, ST); RW_LOAD(A, (ST) + 2); RW_WAIT(B, 7); RW_STEP(B, (ST) + 1); } while (0)
            RW_LOAD(A, 0);
            RW_PAIR(0); RW_PAIR(2); RW_PAIR(4); RW_PAIR(6); RW_PAIR(8); RW_PAIR(10); RW_PAIR(12);
            RW_LOAD(B, 15); RW_WAIT(A, 7); RW_STEP(A, 14); RW_WAIT(B, 0); RW_STEP(B, 15);
#undef RW_PAIR
#undef RW_STEP
#undef RW_WAIT
#undef RW_LOAD
            ylw[(lane & 15) * 16 + loc] = ykeep;
            __syncthreads();
        }
        { const int st = tid >> 4, r = tid & 15; Y[(size_t)(b_r * 2048 + (NCH - 1) * CS + st) * 512 + h_r * 64 + rbase + r] = f2bf(yl[((NCH - 1) & 1) * (CS * 16) + tid]); }
        { f32x4 t; t.xy = S0; t.zw = S1; *(f32x4*)RSp = t; }
    } else {
        const int lt = tid - 256;
        const unsigned char* src[4]; unsigned inc[4]; int dsto[4]; bool isf[4], act[4];
#pragma unroll
        for (int i = 0; i < 4; ++i) {
            int idx = lt + 256 * i; act[i] = idx < CS * 50; idx = act[i] ? idx : CS * 50 - 1;
            const int st = idx / 50, k = idx - st * 50;
            const size_t m = (size_t)(b_r * 2048 + st) * 512 + h_r * 64;
            if (k < 16) { src[i] = (const unsigned char*)(B.Wf + m + k * 4); inc[i] = CS * 512 * 4; dsto[i] = st * RST + k * 4; isf[i] = true; }
            else if (k < 48) { src[i] = (const unsigned char*)(B.KK + (size_t)((k - 16) >> 3) * VEC_STRIDE + m + ((k - 16) & 7) * 8); inc[i] = CS * 512 * 2; dsto[i] = st * RST + 64 * (1 + ((k - 16) >> 3)) + ((k - 16) & 7) * 8; isf[i] = false; }
            else { src[i] = (const unsigned char*)(B.V + m + rbase + (k - 48) * 8); inc[i] = CS * 512 * 2; dsto[i] = st * RST + 320 + (k - 48) * 8; isf[i] = false; }
        }
        const float* c1p = B.C1 + (size_t)(b_r * 2048 + (lt & (CS - 1))) * 8 + h_r; const float* c2p = B.C2 + (size_t)(b_r * 2048 + (lt & (CS - 1))) * 8 + h_r;
        const int e = c * 256 + lt, bhh = e >> 11, hv = (e >> 4) & 127, hk8 = (e & 15) * 8;
        float* HSp = B.HS + ((size_t)bhh * 128 + hv) * 128 + hk8;
        f32x4 h0 = {0.f, 0.f, 0.f, 0.f}, h1 = {0.f, 0.f, 0.f, 0.f};
        if (s == 1) { h0 = *(const f32x4*)HSp; h1 = *(const f32x4*)(HSp + 4); }
        asm volatile("" : "+v"(h0), "+v"(h1));
        u32x4 rrA[4], rrB[4]; float s1A, s2A, s1B, s2B;
        u32x4 Lw = *(const u32x4*)(B.St + ((size_t)(bhh * 32) * 128 + hv) * 128 + hk8);
        f32x4 d0 = *(const f32x4*)(B.DEC + (bhh * 32) * 128 + hk8), d1 = *(const f32x4*)(B.DEC + (bhh * 32) * 128 + hk8 + 4);
#define LD_ISSUE(rr, sc1, sc2) do { _Pragma("unroll") for (int i = 0; i < 4; ++i) { rr[i] = *(const u32x4*)src[i]; src[i] += inc[i]; } sc1 = *c1p; sc2 = *c2p; c1p += CS * 8; c2p += CS * 8; } while (0)
#define LD_STORE(rr, sc1, sc2, par) do { float* rb = rbuf + (par) * (CS * RST); \
            _Pragma("unroll") for (int i = 0; i < 4; ++i) { if (act[i]) { float* dst = rb + dsto[i]; \
                if (isf[i]) { *(u32x4*)dst = rr[i]; } else { f32x4 a, bb; unpack8(rr[i], a, bb); *(f32x4*)dst = a; *(f32x4*)(dst + 4) = bb; } } } \
            if (lt < CS) { rb[lt * RST + 336] = sc1; rb[lt * RST + 337] = sc2; } } while (0)
        LD_ISSUE(rrA, s1A, s2A); LD_STORE(rrA, s1A, s2A, 0); LD_ISSUE(rrA, s1A, s2A);
        __syncthreads();
#pragma unroll 1
        for (int cidx = 0; cidx < NCH; cidx += 4) {
            LD_ISSUE(rrB, s1B, s2B);
            {
                bf16_t* sp = B.St + ((size_t)(bhh * 32 + (cidx >> 2)) * 128 + hv) * 128 + hk8;
                *(u32x4*)sp = pack8(h0, h1);
                f32x4 l0, l1; unpack8(Lw, l0, l1);
                h0 = d0 * h0 + l0; h1 = d1 * h1 + l1;
            }
            LD_STORE(rrA, s1A, s2A, 1);
            __syncthreads();
            LD_ISSUE(rrA, s1A, s2A);
            LD_STORE(rrB, s1B, s2B, 0);
            __syncthreads();
            LD_ISSUE(rrB, s1B, s2B);
            {   const int pn = (cidx >> 2) + 1, item = bhh * 32 + (pn < 32 ? pn : 31);
                Lw = *(const u32x4*)(B.St + ((size_t)item * 128 + hv) * 128 + hk8);
                d0 = *(const f32x4*)(B.DEC + item * 128 + hk8); d1 = *(const f32x4*)(B.DEC + item * 128 + hk8 + 4); }
            LD_STORE(rrA, s1A, s2A, 1);
            __syncthreads();
            LD_ISSUE(rrA, s1A, s2A);
            LD_STORE(rrB, s1B, s2B, 0);
            __syncthreads();
        }
        *(f32x4*)HSp = h0; *(f32x4*)(HSp + 4) = h1;
#undef LD_ISSUE
#undef LD_STORE
    }
}

__device__ __forceinline__ void phase4(int l, unsigned char* shm) {
    const Bufs B = make_bufs(WSP(), l);
    const int lane = tid_v() & 63, gw = bid_s() * 8 + (tid_v() >> 6);
    const float* lnw = IN(15) + l * 512; const float* lnb = IN(16) + l * 512; const float* hn = IN(22) + l * 512;
    bf16_t* Y = B.br + VEC_STRIDE;
    for (int mb = gw; mb < MS; mb += 4096) {
        const int c0 = lane * 8, h = lane >> 3;
        u32x4 yw[2], gwd[2], vwd[2]; float c3v[2];
#pragma unroll
        for (int u = 0; u < 2; ++u) { const size_t o = (size_t)(mb + 2048 * u) * 512 + c0; yw[u] = *(const u32x4*)(Y + o); gwd[u] = *(const u32x4*)(B.G + o); vwd[u] = *(const u32x4*)(B.V + o); c3v[u] = B.C3[(mb + 2048 * u) * 8 + h]; }
        const f32x4 w0 = *(const f32x4*)(lnw + c0), w1 = *(const f32x4*)(lnw + c0 + 4), b0 = *(const f32x4*)(lnb + c0), b1 = *(const f32x4*)(lnb + c0 + 4);
#pragma unroll
        for (int u = 0; u < 2; ++u) {
            const size_t o = (size_t)(mb + 2048 * u) * 512 + c0;
            f32x4 y0, y1, g0, g1, v0, v1;
            unpack8(yw[u], y0, y1); unpack8(gwd[u], g0, g1); unpack8(vwd[u], v0, v1);
            const float c3 = c3v[u];
            const float mean = rsum8((y0[0] + y0[1]) + (y0[2] + y0[3]) + (y1[0] + y1[1]) + (y1[2] + y1[3])) * (1.0f / 64.0f);
            const f32x4 d0 = y0 - mean, d1 = y1 - mean;
            const float var = rsum8(d0[0] * d0[0] + d0[1] * d0[1] + d0[2] * d0[2] + d0[3] * d0[3] + d1[0] * d1[0] + d1[1] * d1[1] + d1[2] * d1[2] + d1[3] * d1[3]) * (1.0f / 64.0f);
            const float rstd = rsqrtf(var + 64e-5f);
            const f32x4 r0 = (d0 * rstd * w0 + b0 + c3 * v0) * g0, r1 = (d1 * rstd * w1 + b1 + c3 * v1) * g1;
            *(u32x4*)(Y + o) = pack8(r0, r1);
        }
    }
    const float* hlb = IN(21);
    for (int it = bid_s(); it < 1024; it += gridDim.x) hgC_item(B, l, it, shm, hlb, hn);
}

__device__ __forceinline__ void phase8(int l, int s) {
    const Bufs B = make_bufs(WSP(), l);
    const float* cw = IN(27) + (size_t)l * 3 * 5632; const float* cb = IN(28) + (size_t)l * 5632;
    const int tid = tid_v();
    if (tid >= 352) return;
    const int j0 = tid * 8;
    f32x4 wg[3][2], wv[3][2], bg[2], bv[2];
#pragma unroll
    for (int e = 0; e < 2; ++e) {
        bg[e] = *(const f32x4*)(cb + j0 + 4 * e); bv[e] = *(const f32x4*)(cb + 2816 + j0 + 4 * e);
#pragma unroll
        for (int tap = 0; tap < 3; ++tap) { wg[tap][e] = *(const f32x4*)(cw + (size_t)tap * 5632 + j0 + 4 * e); wv[tap][e] = *(const f32x4*)(cw + (size_t)tap * 5632 + 2816 + j0 + 4 * e); }
    }
    const u32x4 zero4 = {0u, 0u, 0u, 0u};
    for (int blk = bid_s(); blk < MS / 64; blk += gridDim.x) {
        const int mbeg = blk * 64, b = mbeg >> 11, tl0 = mbeg & 2047;
        const bf16_t* ub = B.bufU + (size_t)mbeg * 5632 + j0;
        u32x4 hg1, hv1, hg2, hv2;
        if (tl0 > 0) { hg1 = *(const u32x4*)(ub - 5632); hv1 = *(const u32x4*)(ub - 5632 + 2816); hg2 = *(const u32x4*)(ub - 2 * 5632); hv2 = *(const u32x4*)(ub - 2 * 5632 + 2816); }
        else if (s == 1) { const bf16_t* sp = B.saveU + (size_t)(b * 2) * 5632 + j0; hg1 = *(const u32x4*)(sp + 5632); hv1 = *(const u32x4*)(sp + 5632 + 2816); hg2 = *(const u32x4*)sp; hv2 = *(const u32x4*)(sp + 2816); }
        else { hg1 = zero4; hv1 = zero4; hg2 = zero4; hv2 = zero4; }
        f32x4 g1[2], v1[2], g2[2], v2[2];
        unpack8(hg1, g1[0], g1[1]); unpack8(hv1, v1[0], v1[1]); unpack8(hg2, g2[0], g2[1]); unpack8(hv2, v2[0], v2[1]);
#pragma unroll 1
        for (int r0 = 0; r0 < 64; r0 += 4) {
            u32x4 gw[4], vw[4];
#pragma unroll
            for (int q = 0; q < 4; ++q) { gw[q] = *(const u32x4*)(ub + (size_t)(r0 + q) * 5632); vw[q] = *(const u32x4*)(ub + (size_t)(r0 + q) * 5632 + 2816); }
#pragma unroll
            for (int q = 0; q < 4; ++q) {
                const int m = mbeg + r0 + q, tl = tl0 + r0 + q;
                if (s == 0 && tl >= 2046) { bf16_t* sp = B.saveU + (size_t)(b * 2 + tl - 2046) * 5632 + j0; *(u32x4*)sp = gw[q]; *(u32x4*)(sp + 2816) = vw[q]; }
                f32x4 gc[2], vc[2]; unpack8(gw[q], gc[0], gc[1]); unpack8(vw[q], vc[0], vc[1]);
                f32x4 og[2], ov[2];
#pragma unroll
                for (int e = 0; e < 2; ++e) {
                    og[e] = bg[e] + wg[2][e] * gc[e] + wg[1][e] * g1[e] + wg[0][e] * g2[e];
                    ov[e] = bv[e] + wv[2][e] * vc[e] + wv[1][e] * v1[e] + wv[0][e] * v2[e];
#pragma unroll
                    for (int j = 0; j < 4; ++j) og[e][j] = gelu_t(og[e][j]) * ov[e][j];
                    g2[e] = g1[e]; v2[e] = v1[e]; g1[e] = gc[e]; v1[e] = vc[e];
                }
                *(u32x4*)(B.act + (size_t)m * 2816 + j0) = pack8(og[0], og[1]);
            }
        }
    }
}

__device__ __forceinline__ void phase_final() {
    float* outp = OUTP();
    const int lane = tid_v() & 63, gw = bid_s() * 8 + (tid_v() >> 6);
    const f32x4* gm = (const f32x4*)IN(33);
    for (int mb = gw; mb < 32768; mb += 4096) {
        f32x4 v[2][4];
#pragma unroll
        for (int u = 0; u < 2; ++u) { const f32x4* xr = (const f32x4*)(outp + (size_t)(mb + 2048 * u) * 1024);
#pragma unroll
            for (int i = 0; i < 4; ++i) v[u][i] = xr[lane + 64 * i]; }
#pragma unroll
        for (int u = 0; u < 2; ++u) { f32x4* xr = (f32x4*)(outp + (size_t)(mb + 2048 * u) * 1024); float sum = 0.f;
#pragma unroll
            for (int i = 0; i < 4; ++i) sum += v[u][i][0] * v[u][i][0] + v[u][i][1] * v[u][i][1] + v[u][i][2] * v[u][i][2] + v[u][i][3] * v[u][i][3];
            sum = wsum(sum);
            const float rs = rsqrtf(sum * (1.0f / 1024.0f) + 1e-6f);
#pragma unroll
            for (int i = 0; i < 4; ++i) xr[lane + 64 * i] = v[u][i] * rs * gm[lane + 64 * i]; }
    }
}

__global__ void __launch_bounds__(512, 2) mega(Params p) {
    extern __shared__ __attribute__((aligned(16))) unsigned char shm[];
    cg::grid_group grid = cg::this_grid();
    PG8_LAS unsigned char* lds = (PG8_LAS unsigned char*)shm;
    constexpr int G = 256; const int c = (int)bid_s();
    volatile PG8_LAS unsigned* bst = (volatile PG8_LAS unsigned*)(lds + 131072);
    if (tid_v() < 4) bst[tid_v()] = 0u;
    __syncthreads();
    const XcdBarrier xb = xcd_barrier_post((unsigned*)(WSP() + BAR_OFF), bst);
    phase0(shm);
    phaseX(0, 0);
    grid.sync();
#pragma unroll 1
    for (int ls = 0; ls < 4; ++ls) {
        const int l = ls >> 1, s = ls & 1;
        if (ls != 0) { phaseX(l, s); xcd_barrier(xb); }
        {
            const Bufs B = make_bufs(WSP(), l);
            StaticOrder S; S.init(MS, 4864, G, c);
            EpiProj E{B.ss0, B.bufA, B.bufB, B.bufC, B.bufD};
            gemm_phase(lds, Gemm{B.xb, B.W + oWin, MS, 4864, 1024}, S, E);
        }
        xcd_barrier(xb);
        phase2(l, s, shm);
        xcd_barrier(xb);
        scans(l, s, shm);
        xcd_barrier(xb);
        phase4(l, shm);
        xcd_barrier(xb);
        {
            const Bufs B = make_bufs(WSP(), l);
            StaticOrder S0; S0.init(MS, 1024, G, c);
            P5Order S; S0.next(0, S.t); S.xb = B.xb; S.Wg = B.W + oWin + (size_t)4864 * 1024; S.br = B.br; S.Wb = B.W + oWb; S.brs = VEC_STRIDE;
            EpiP5 E{B.ss0, B.gates, B.mrg, B.mb};
            gemm_phase_x(lds, S, E);
        }
        xcd_barrier(xb);
        {
            const Bufs B = make_bufs(WSP(), l);
            StaticOrder S; S.init(MS, 1024, G, c);
            EpiRes E{l == 0 ? IN(0) : OUTP(), OUTP(), B.xb, B.ss1, s};
            gemm_phase(lds, Gemm{B.mb, B.W + oWo, MS, 1024, launder_s(1024)}, S, E);
        }
        xcd_barrier(xb);
        {
            const Bufs B = make_bufs(WSP(), l);
            StaticOrder S; S.init(MS, 5632, G, c);
            EpiBf<0> E{B.ss1, B.bufU, 5632};
            gemm_phase(lds, Gemm{B.xb, B.W + oWup, MS, 5632, launder_s(1024)}, S, E);
        }
        xcd_barrier(xb);
        phase8(l, s);
        xcd_barrier(xb);
        {
            const Bufs B = make_bufs(WSP(), l);
            StaticOrder S; S.init(MS, 1024, G, c);
            EpiRes E{OUTP(), OUTP(), B.xb, B.ss2, s};
            gemm_phase(lds, Gemm{B.act, B.W + oWd, MS, 1024, launder_s(2816)}, S, E);
        }
        xcd_barrier(xb);
        {
            const Bufs B = make_bufs(WSP(), l);
            StaticOrder S0; S0.init(MS, 1024, G, c);
            P10Order S; S0.next(0, S.t); S.pb = B.pb; S.Wp = B.W + oWp; S.xb = B.xb; S.Wg = B.W + oWg;
            EpiP10 E{B.ss2, B.pp, OUTP(), s};
            gemm_phase_x(lds, S, E);
        }
        xcd_barrier(xb);
    }
    phase_final();
}

extern "C" void kernel_launch(void* const* d_in, const int* in_sizes, int n_in, void* d_out, int out_size,
                              void* d_ws, size_t ws_size, hipStream_t stream) {
    constexpr size_t kDynLds = 131072 + 64;
    static int grid_blocks = 0;
    if (!grid_blocks) {
        (void)hipFuncSetAttribute((const void*)mega, hipFuncAttributeMaxDynamicSharedMemorySize, (int)kDynLds);
        int dev = 0, cus = 0, per_cu = 0;
        (void)hipGetDevice(&dev);
        (void)hipDeviceGetAttribute(&cus, hipDeviceAttributeMultiprocessorCount, dev);
        (void)hipOccupancyMaxActiveBlocksPerMultiprocessor(&per_cu, mega, 512, kDynLds);
        grid_blocks = cus * per_cu;
        if (grid_blocks > 256) grid_blocks = 256;
        if (grid_blocks != 256) { fprintf(stderr, "this kernel needs 256 co-resident workgroups, got %d\n", grid_blocks); grid_blocks = 0; }
    }
    Params p{};
    for (int i = 0; i < 34; ++i) p.in[i] = (const float*)d_in[i];
    p.out = (float*)d_out; p.ws = (unsigned char*)d_ws;
    (void)hipMemsetAsync((unsigned char*)d_ws + BAR_OFF, 0, XCD_BAR_WORDS * sizeof(unsigned), stream);
    void* args[] = {&p};
    if (grid_blocks != 256) return;
    hipError_t e = hipLaunchCooperativeKernel((void*)mega, dim3(grid_blocks), dim3(512), args, kDynLds, stream);
    if (e != hipSuccess) fprintf(stderr, "cooperative launch failed: %s (grid %d)\n", hipGetErrorString(e), grid_blocks);
}
```

```cpp
#include <hip/hip_runtime.h>
#include <hip/hip_cooperative_groups.h>
#include <cstdio>
namespace cg = cooperative_groups;

#define PG8_LAS __attribute__((address_space(3)))
typedef unsigned short bf16_t;
typedef short bf16x8 __attribute__((ext_vector_type(8)));
typedef float f32x4 __attribute__((ext_vector_type(4)));
typedef float f32x2 __attribute__((ext_vector_type(2)));
typedef unsigned u32x4 __attribute__((ext_vector_type(4)));
typedef unsigned u32x2 __attribute__((ext_vector_type(2)));
constexpr int BM = 256, BK = 64, HALF = 128, HTB = HALF * BK * 2, STAGE_BYTES = 8 * HTB, NXCD = 8, WGM = 8;

__host__ __device__ __forceinline__ int lds_byte(int r, int c) { const int st = (r >> 4) * 2 + (c >> 5), rr = r & 15, cc = c & 31, ob = rr * 64 + cc * 2; return st * 1024 + (ob ^ (((ob >> 9) & 1) << 5)); }
__host__ __device__ __forceinline__ void stage_rc(int b, int& R, int& C) { const int st = b / 1024, sb = b % 1024, swz = sb ^ (((sb >> 9) & 1) << 5); R = (st >> 1) * 16 + swz / 64; C = (st & 1) * 32 + (swz % 64) / 2; }
__host__ __device__ __forceinline__ int perm32(int rho) { const int n = rho >> 4, i = rho & 15; return 8 * (i >> 2) + 4 * n + (i & 3); }

__device__ __forceinline__ int tid_v() { int t = threadIdx.x; asm volatile("" : "+v"(t)); return t; }
__device__ __forceinline__ int bid_s() { int b = blockIdx.x; asm volatile("" : "+s"(b)); return b; }
struct Unit { int pm, pn; };
struct Gemm { const bf16_t* A; const bf16_t* Bt; int M, N, K; };

struct StaticOrder {
    int nM, nN, nwg, G, c;
    __host__ __device__ void init(int M, int N, int G_, int c_) { nM = M / BM; nN = N / BM; nwg = nM * nN; G = G_; c = c_; }
    __host__ __device__ bool next(int i, Unit& u) const {
        const long L = (long)i * G + c; if (L >= nwg) return false;
        int wgid = (int)L; { const int q = nwg / NXCD, r = nwg % NXCD, xcd = wgid % NXCD, off = wgid / NXCD; wgid = (xcd < r ? xcd * (q + 1) : r * (q + 1) + (xcd - r) * q) + off; }
        const int nig = WGM * nN, gid = wgid / nig, fm = gid * WGM, gsz = (nM - fm) < WGM ? (nM - fm) : WGM;
        u.pm = fm + ((wgid % nig) % gsz); u.pn = (wgid % nig) / gsz; return true;
    }
    __device__ __forceinline__ void a_ready(const Unit&) const {}
    __device__ __forceinline__ void done(const Unit&) const {}
};

typedef __bf16 bf16x2_t __attribute__((ext_vector_type(2)));
__device__ __forceinline__ unsigned cvt_pk_bf16(float lo, float hi) { const f32x2 v = {lo, hi}; return __builtin_bit_cast(unsigned, __builtin_convertvector(v, bf16x2_t)); }
__device__ __forceinline__ float bf2f(bf16_t b) { return __uint_as_float(((unsigned)b) << 16); }
__device__ __forceinline__ float bflo(unsigned w) { return __uint_as_float(w << 16); }
__device__ __forceinline__ float bfhi(unsigned w) { return __uint_as_float(w & 0xffff0000u); }
__device__ __forceinline__ bf16_t f2bf(float f) { unsigned u = __float_as_uint(f); u += 0x7FFFu + ((u >> 16) & 1u); return (bf16_t)(u >> 16); }
__device__ __forceinline__ float sigm(float x) { return __builtin_amdgcn_rcpf(1.0f + __expf(-x)); }
__device__ __forceinline__ float gelu_t(float x) { return x * __builtin_amdgcn_rcpf(1.0f + __expf(-1.5957691216f * (x + 0.044715f * x * x * x))); }
__device__ __forceinline__ float silu_f(float x) { return x * __builtin_amdgcn_rcpf(1.0f + __expf(-x)); }
__device__ __forceinline__ float wsum(float v) {
#pragma unroll
    for (int o = 32; o; o >>= 1) v += __shfl_xor(v, o);
    return v;
}
template <int CTRL> __device__ __forceinline__ float dppf(float v) { return __int_as_float(__builtin_amdgcn_update_dpp(0, __float_as_int(v), CTRL, 0xf, 0xf, true)); }
__device__ __forceinline__ float rsum16(float v) {
    v += dppf<0xB1>(v); v += dppf<0x4E>(v); v += dppf<0x141>(v); v += dppf<0x140>(v); return v;
}

__device__ __forceinline__ u32x4 pack8(const f32x4& v0, const f32x4& v1) { u32x4 w; w.x = cvt_pk_bf16(v0[0], v0[1]); w.y = cvt_pk_bf16(v0[2], v0[3]); w.z = cvt_pk_bf16(v1[0], v1[1]); w.w = cvt_pk_bf16(v1[2], v1[3]); return w; }
__device__ __forceinline__ void unpack8(const u32x4& w, f32x4& v0, f32x4& v1) { v0[0] = bflo(w.x); v0[1] = bfhi(w.x); v0[2] = bflo(w.y); v0[3] = bfhi(w.y); v1[0] = bflo(w.z); v1[1] = bfhi(w.z); v1[2] = bflo(w.w); v1[3] = bfhi(w.w); }

struct EpiProj {
    static constexpr bool PERM = true, AFTER_DRAIN = false;
    const float* ss; bf16_t* bA; bf16_t* bB; bf16_t* bC; bf16_t* bD;
    __device__ __forceinline__ void operator()(const f32x4 (&acc)[2][2][4][2], const Unit& u, int wr, int wc, int fr, int fq) const {
        const int pn = u.pn; bf16_t* base; int ld, coff, act;
        if (pn < 2) { base = bA; ld = 512; coff = pn * 256; act = 0; }
        else if (pn < 9) { base = bB; ld = 1792; coff = (pn - 2) * 256; act = 0; }
        else if (pn < 13) { base = bC; ld = 1024; coff = (pn - 9) * 256; act = 1; }
        else { base = bD; ld = 1536; coff = (pn - 13) * 256; act = pn < 15 ? 2 : (pn < 17 ? 4 : 0); }
        const int row0 = u.pm * BM + wr * 64 + fr, col0 = coff + wc * 32 + 8 * fq;
#pragma unroll
        for (int ai = 0; ai < 2; ++ai)
#pragma unroll
            for (int m = 0; m < 4; ++m) {
                const int row = row0 + ai * HALF + m * 16;
                bf16_t* rowp = base + (size_t)row * ld + col0;
#pragma unroll
                for (int bj = 0; bj < 2; ++bj) {
                    f32x4 v0 = acc[ai][bj][m][0], v1 = acc[ai][bj][m][1];
                    if (act == 1) {
#pragma unroll
                        for (int j = 0; j < 4; ++j) { v0[j] = gelu_t(v0[j]); v1[j] = gelu_t(v1[j]); }
                    } else if (act == 2) {
#pragma unroll
                        for (int j = 0; j < 4; ++j) { v0[j] = silu_f(v0[j]); v1[j] = silu_f(v1[j]); }
                    } else if (act == 4) {
#pragma unroll
                        for (int j = 0; j < 4; ++j) { v0[j] = sigm(-v0[j]); v1[j] = sigm(-v1[j]); }
                    }
                    *(u32x4*)(rowp + bj * HALF) = pack8(v0, v1);
                }
            }
    }
};

template <int ACT  > struct EpiBf {
    static constexpr bool PERM = true, AFTER_DRAIN = false;
    const float* ss; bf16_t* out; int ld;
    __device__ __forceinline__ void operator()(const f32x4 (&acc)[2][2][4][2], const Unit& u, int wr, int wc, int fr, int fq) const {
        const int row0 = u.pm * BM + wr * 64 + fr, col0 = u.pn * BM + wc * 32 + 8 * fq;
#pragma unroll
        for (int ai = 0; ai < 2; ++ai)
#pragma unroll
            for (int m = 0; m < 4; ++m) {
                const int row = row0 + ai * HALF + m * 16;
                const float rs = ss ? rsqrtf(ss[row] * (1.0f / 1024.0f) + 1e-6f) : 1.0f;
                bf16_t* rowp = out + (size_t)row * ld + col0;
#pragma unroll
                for (int bj = 0; bj < 2; ++bj) {
                    f32x4 v0 = acc[ai][bj][m][0] * rs, v1 = acc[ai][bj][m][1] * rs;
                    if (ACT == 3) {
#pragma unroll
                        for (int j = 0; j < 4; ++j) { v0[j] = sigm(v0[j]); v1[j] = sigm(v1[j]); }
                    }
                    *(u32x4*)(rowp + bj * HALF) = pack8(v0, v1);
                }
            }
    }
};

struct EpiBranch {
    static constexpr bool PERM = true, AFTER_DRAIN = false;
    const bf16_t* gates; float* mrg; bf16_t* mb; int kb;
    __device__ __forceinline__ void operator()(const f32x4 (&acc)[2][2][4][2], const Unit& u, int wr, int wc, int fr, int fq) const {
        const int row0 = u.pm * BM + wr * 64 + fr, col0 = u.pn * BM + wc * 32 + 8 * fq;
#pragma unroll
        for (int ai = 0; ai < 2; ++ai)
#pragma unroll
            for (int m = 0; m < 4; ++m) {
                const int row = row0 + ai * HALF + m * 16;
#pragma unroll
                for (int bj = 0; bj < 2; ++bj) {
                    const size_t idx = (size_t)row * 1024 + col0 + bj * HALF;
                    const u32x4 gw = *(const u32x4*)(gates + idx);
                    f32x4 g0, g1; unpack8(gw, g0, g1);
                    f32x4 m0 = {0.f, 0.f, 0.f, 0.f}, m1 = {0.f, 0.f, 0.f, 0.f};
                    if (kb > 0) { m0 = *(const f32x4*)(mrg + idx); m1 = *(const f32x4*)(mrg + idx + 4); }
                    m0 += g0 * acc[ai][bj][m][0]; m1 += g1 * acc[ai][bj][m][1];
                    if (kb < 3) { *(f32x4*)(mrg + idx) = m0; *(f32x4*)(mrg + idx + 4) = m1; }
                    else *(u32x4*)(mb + idx) = pack8(m0, m1);
                }
            }
    }
};

struct EpiRes {
    static constexpr bool PERM = true, AFTER_DRAIN = false;
    const float* xin; float* xout; bf16_t* xb; float* ssn; int s;
    __device__ __forceinline__ void operator()(const f32x4 (&acc)[2][2][4][2], const Unit& u, int wr, int wc, int fr, int fq) const {
        const int row0 = u.pm * BM + wr * 64 + fr, col0 = u.pn * BM + wc * 32 + 8 * fq;
#pragma unroll
        for (int ai = 0; ai < 2; ++ai)
#pragma unroll
            for (int m = 0; m < 4; ++m) {
                const int row = row0 + ai * HALF + m * 16;
                const size_t rowg = (size_t)((row >> 11) * 4096 + s * 2048 + (row & 2047));
                float sq = 0.f;
#pragma unroll
                for (int bj = 0; bj < 2; ++bj) {
                    const size_t gi = rowg * 1024 + col0 + bj * HALF;
                    f32x4 x0 = *(const f32x4*)(xin + gi), x1 = *(const f32x4*)(xin + gi + 4);
                    x0 += acc[ai][bj][m][0]; x1 += acc[ai][bj][m][1];
                    *(f32x4*)(xout + gi) = x0; *(f32x4*)(xout + gi + 4) = x1;
                    *(u32x4*)(xb + (size_t)row * 1024 + col0 + bj * HALF) = pack8(x0, x1);
                    sq += x0[0] * x0[0] + x0[1] * x0[1] + x0[2] * x0[2] + x0[3] * x0[3] + x1[0] * x1[0] + x1[1] * x1[1] + x1[2] * x1[2] + x1[3] * x1[3];
                }
                sq += __shfl_xor(sq, 16); sq += __shfl_xor(sq, 32);
                if (fq == 0) atomicAdd(ssn + row, sq);
            }
    }
};

struct EpiPle {
    static constexpr bool PERM = true, AFTER_DRAIN = false;
    const float* ss; const bf16_t* pp; float* x; int s;
    __device__ __forceinline__ void operator()(const f32x4 (&acc)[2][2][4][2], const Unit& u, int wr, int wc, int fr, int fq) const {
        const int row0 = u.pm * BM + wr * 64 + fr, col0 = u.pn * BM + wc * 32 + 8 * fq;
#pragma unroll
        for (int ai = 0; ai < 2; ++ai)
#pragma unroll
            for (int m = 0; m < 4; ++m) {
                const int row = row0 + ai * HALF + m * 16;
                const size_t rowg = (size_t)((row >> 11) * 4096 + s * 2048 + (row & 2047));
                const float rs = rsqrtf(ss[row] * (1.0f / 1024.0f) + 1e-6f);
#pragma unroll
                for (int bj = 0; bj < 2; ++bj) {
                    const size_t gi = rowg * 1024 + col0 + bj * HALF;
                    const u32x4 pw = *(const u32x4*)(pp + (size_t)row * 1024 + col0 + bj * HALF);
                    f32x4 p0, p1; unpack8(pw, p0, p1);
                    f32x4 x0 = *(const f32x4*)(x + gi), x1 = *(const f32x4*)(x + gi + 4);
#pragma unroll
                    for (int j = 0; j < 4; ++j) { x0[j] += p0[j] * sigm(acc[ai][bj][m][0][j] * rs); x1[j] += p1[j] * sigm(acc[ai][bj][m][1][j] * rs); }
                    *(f32x4*)(x + gi) = x0; *(f32x4*)(x + gi + 4) = x1;
                }
            }
    }
};

struct UnitX { int pm, pn; const bf16_t* A; const bf16_t* Bt; int K; int kind; int kb; };
template <class Epi, class Sched>
__device__ __forceinline__ void gemm_phase(PG8_LAS unsigned char* lds, const Gemm g, const Sched& S, const Epi& E) {
    const int tid = tid_v(), wid = __builtin_amdgcn_readfirstlane(tid >> 6), lane = tid & 63, wr = wid >> 2, wc = wid & 3, fr = lane & 15, fq = lane >> 4;
    const int K = g.K, nt = K / BK;
    unsigned voffA[2], voffB[2];
#pragma unroll
    for (int i = 0; i < 2; ++i) { int R, C; stage_rc(tid * 16 + i * 8192, R, C); const int Rb = Epi::PERM ? ((R & ~31) + perm32(R & 31)) : R;
        voffA[i] = (unsigned)(R * K + C) * 2u; voffB[i] = (unsigned)(Rb * K + C) * 2u; }
    const size_t kstep = (size_t)(BK * 2);
    const size_t hstep = (size_t)HALF * K * 2;
    const size_t tstep = 2 * hstep;
    const unsigned ldsw = (unsigned)wid * 1024u;
    const int aoff = lds_byte(wr * 64 + fr, fq * 8), boff = lds_byte(wc * 32 + fr, fq * 8);
#define PG8_SA(b, h) (((b) * 2 + (h)) * HTB)
#define PG8_SB(b, h) ((4 + (b) * 2 + (h)) * HTB)
#define PG8_STAGE(bufoff, gbase, voff) do { _Pragma("unroll") for (int _i = 0; _i < 2; ++_i) \
        __builtin_amdgcn_global_load_lds((const unsigned*)((const char*)(gbase) + (voff)[_i]), (PG8_LAS unsigned*)(lds + (bufoff) + ldsw + _i * 8192), 16, 0, 0); } while (0)
#define PG8_LDA(dst, b, h) do { _Pragma("unroll") for (int m = 0; m < 4; ++m) _Pragma("unroll") for (int k = 0; k < 2; ++k) dst[m][k] = *(const PG8_LAS bf16x8*)(lds + PG8_SA(b, h) + aoff + m * 2048 + k * 1024); } while (0)
#define PG8_LDB(dst, b, h) do { _Pragma("unroll") for (int n = 0; n < 2; ++n) _Pragma("unroll") for (int k = 0; k < 2; ++k) dst[n][k] = *(const PG8_LAS bf16x8*)(lds + PG8_SB(b, h) + boff + n * 2048 + k * 1024); } while (0)
#define PG8_MMA(ai, bj, At, Bt) do { __builtin_amdgcn_s_setprio(1); _Pragma("unroll") for (int m = 0; m < 4; ++m) _Pragma("unroll") for (int n = 0; n < 2; ++n) _Pragma("unroll") for (int k = 0; k < 2; ++k) \
        acc[ai][bj][m][n] = __builtin_amdgcn_mfma_f32_16x16x32_bf16(Bt[n][k], At[m][k], acc[ai][bj][m][n], 0, 0, 0); __builtin_amdgcn_s_setprio(0); } while (0)
#define PG8_WAIT_V(n) asm volatile("s_waitcnt vmcnt(" #n ")" ::: "memory")
#define PG8_WAIT_L(n) asm volatile("s_waitcnt lgkmcnt(" #n ")" ::: "memory")
#define PG8_BAR __builtin_amdgcn_s_barrier()
#define PG8_SCHED __builtin_amdgcn_sched_barrier(0)
    Unit cur, nxt; int ui = 0;
    if (!S.next(0, cur)) return;
    f32x4 acc[2][2][4][2];
#pragma unroll
    for (int a = 0; a < 2; ++a)
#pragma unroll
        for (int b = 0; b < 2; ++b)
#pragma unroll
            for (int m = 0; m < 4; ++m)
#pragma unroll
                for (int n = 0; n < 2; ++n) acc[a][b][m][n] = (f32x4){0.f, 0.f, 0.f, 0.f};
    bf16x8 At[4][2], B0[2][2], B1[2][2];
    const char* cA = (const char*)g.A + (size_t)cur.pm * tstep; const char* cB = (const char*)g.Bt + (size_t)cur.pn * tstep;
    S.a_ready(cur);
    PG8_STAGE(PG8_SB(0, 0), cB, voffB); PG8_STAGE(PG8_SA(0, 0), cA, voffA); PG8_STAGE(PG8_SB(0, 1), cB + hstep, voffB); PG8_STAGE(PG8_SA(0, 1), cA + hstep, voffA);
    if (wr == 1) PG8_BAR;
    PG8_WAIT_V(4); PG8_BAR;
    PG8_STAGE(PG8_SB(1, 0), cB + kstep, voffB); PG8_STAGE(PG8_SA(1, 0), cA + kstep, voffA); PG8_STAGE(PG8_SB(1, 1), cB + hstep + kstep, voffB);
    PG8_WAIT_V(6); PG8_BAR;
    for (;;) {
        const bool has_next = S.next(ui + 1, nxt);
        const char* nA = has_next ? (const char*)g.A + (size_t)nxt.pm * tstep : cA; const char* nB = has_next ? (const char*)g.Bt + (size_t)nxt.pn * tstep : cB;
        for (int t = 0; t < nt; t += 2) {
            const bool last = (t == nt - 2);
            const char* a1 = cA + (size_t)(t + 1) * kstep;
            const char* a2 = last ? nA : cA + (size_t)(t + 2) * kstep; const char* b2 = last ? nB : cB + (size_t)(t + 2) * kstep;
            const char* a3 = a2 + kstep; const char* b3 = b2 + kstep;
            if (last && has_next) S.a_ready(nxt);
            PG8_LDB(B0, 0, 0); PG8_SCHED; PG8_LDA(At, 0, 0); PG8_STAGE(PG8_SA(1, 1), a1 + hstep, voffA);
            PG8_WAIT_L(8); PG8_BAR; PG8_WAIT_L(0); PG8_MMA(0, 0, At, B0); PG8_BAR; PG8_SCHED;
            PG8_LDB(B1, 0, 1); PG8_STAGE(PG8_SB(0, 0), b2, voffB);
            PG8_BAR; PG8_WAIT_L(0); PG8_MMA(0, 1, At, B1); PG8_BAR;
            PG8_LDA(At, 0, 1); PG8_STAGE(PG8_SA(0, 0), a2, voffA);
            PG8_BAR; PG8_WAIT_L(0); PG8_MMA(1, 0, At, B0); PG8_BAR; PG8_SCHED;
            PG8_STAGE(PG8_SB(0, 1), b2 + hstep, voffB);
            PG8_WAIT_V(6); PG8_BAR; PG8_MMA(1, 1, At, B1); PG8_BAR;
            PG8_LDB(B0, 1, 0); PG8_SCHED; PG8_LDA(At, 1, 0); PG8_STAGE(PG8_SA(0, 1), a2 + hstep, voffA);
            PG8_WAIT_L(8); PG8_BAR; PG8_WAIT_L(0); PG8_MMA(0, 0, At, B0); PG8_BAR; PG8_SCHED;
            PG8_LDB(B1, 1, 1); PG8_STAGE(PG8_SB(1, 0), b3, voffB);
            PG8_BAR; PG8_WAIT_L(0); PG8_MMA(0, 1, At, B1); PG8_BAR;
            PG8_LDA(At, 1, 1); PG8_STAGE(PG8_SA(1, 0), a3, voffA);
            PG8_BAR; PG8_WAIT_L(0); PG8_MMA(1, 0, At, B0); PG8_BAR; PG8_SCHED;
            PG8_STAGE(PG8_SB(1, 1), b3 + hstep, voffB);
            PG8_WAIT_V(6); PG8_BAR; PG8_MMA(1, 1, At, B1); PG8_BAR;
        }
        if constexpr (!Epi::AFTER_DRAIN) { E(acc, cur, wr, wc, fr, fq); S.done(cur); }
        if (!has_next) break;
#pragma unroll
        for (int a = 0; a < 2; ++a)
#pragma unroll
            for (int b = 0; b < 2; ++b)
#pragma unroll
                for (int m = 0; m < 4; ++m)
#pragma unroll
                    for (int n = 0; n < 2; ++n) acc[a][b][m][n] = (f32x4){0.f, 0.f, 0.f, 0.f};
        cur = nxt; cA = nA; cB = nB; ++ui;
    }
    PG8_WAIT_V(0);
    if (wr == 0) PG8_BAR;
    PG8_BAR;
    if constexpr (Epi::AFTER_DRAIN) { E.fused(acc, cur, wr, wc, fr, fq, lds, wid, lane); S.done(cur); }
#undef PG8_SA
#undef PG8_SB
#undef PG8_STAGE
#undef PG8_LDA
#undef PG8_LDB
#undef PG8_MMA
#undef PG8_WAIT_V
#undef PG8_WAIT_L
#undef PG8_BAR
#undef PG8_SCHED
}

template <class Epi, class Sched>
__device__ __forceinline__ void gemm_phase_x(PG8_LAS unsigned char* lds, const Sched& S, const Epi& E) {
    const int tid = tid_v(), wid = __builtin_amdgcn_readfirstlane(tid >> 6), lane = tid & 63, wr = wid >> 2, wc = wid & 3, fr = lane & 15, fq = lane >> 4;
    UnitX cur, nxt; int ui = 0;
    if (!S.next(0, cur)) return;
    int K = cur.K, nt = K / BK;
    unsigned voffA[2], voffB[2], nvoffA[2], nvoffB[2];
#pragma unroll
    for (int i = 0; i < 2; ++i) { int R, C; stage_rc(tid * 16 + i * 8192, R, C); const int Rb = Epi::PERM ? ((R & ~31) + perm32(R & 31)) : R;
        voffA[i] = (unsigned)(R * K + C) * 2u; voffB[i] = (unsigned)(Rb * K + C) * 2u; }
    const size_t kstep = (size_t)(BK * 2);
    size_t hstep = (size_t)HALF * K * 2;
    size_t tstep = 2 * hstep;
    const unsigned ldsw = (unsigned)wid * 1024u;
    const int aoff = lds_byte(wr * 64 + fr, fq * 8), boff = lds_byte(wc * 32 + fr, fq * 8);
#define PG8_SA(b, h) (((b) * 2 + (h)) * HTB)
#define PG8_SB(b, h) ((4 + (b) * 2 + (h)) * HTB)
#define PG8_STAGE(bufoff, gbase, voff) do { _Pragma("unroll") for (int _i = 0; _i < 2; ++_i) \
        __builtin_amdgcn_global_load_lds((const unsigned*)((const char*)(gbase) + (voff)[_i]), (PG8_LAS unsigned*)(lds + (bufoff) + ldsw + _i * 8192), 16, 0, 0); } while (0)
#define PG8_LDA(dst, b, h) do { _Pragma("unroll") for (int m = 0; m < 4; ++m) _Pragma("unroll") for (int k = 0; k < 2; ++k) dst[m][k] = *(const PG8_LAS bf16x8*)(lds + PG8_SA(b, h) + aoff + m * 2048 + k * 1024); } while (0)
#define PG8_LDB(dst, b, h) do { _Pragma("unroll") for (int n = 0; n < 2; ++n) _Pragma("unroll") for (int k = 0; k < 2; ++k) dst[n][k] = *(const PG8_LAS bf16x8*)(lds + PG8_SB(b, h) + boff + n * 2048 + k * 1024); } while (0)
#define PG8_MMA(ai, bj, At, Bt) do { __builtin_amdgcn_s_setprio(1); _Pragma("unroll") for (int m = 0; m < 4; ++m) _Pragma("unroll") for (int n = 0; n < 2; ++n) _Pragma("unroll") for (int k = 0; k < 2; ++k) \
        acc[ai][bj][m][n] = __builtin_amdgcn_mfma_f32_16x16x32_bf16(Bt[n][k], At[m][k], acc[ai][bj][m][n], 0, 0, 0); __builtin_amdgcn_s_setprio(0); } while (0)
#define PG8_WAIT_V(n) asm volatile("s_waitcnt vmcnt(" #n ")" ::: "memory")
#define PG8_WAIT_L(n) asm volatile("s_waitcnt lgkmcnt(" #n ")" ::: "memory")
#define PG8_BAR __builtin_amdgcn_s_barrier()
#define PG8_SCHED __builtin_amdgcn_sched_barrier(0)
    f32x4 acc[2][2][4][2];
#pragma unroll
    for (int a = 0; a < 2; ++a)
#pragma unroll
        for (int b = 0; b < 2; ++b)
#pragma unroll
            for (int m = 0; m < 4; ++m)
#pragma unroll
                for (int n = 0; n < 2; ++n) acc[a][b][m][n] = (f32x4){0.f, 0.f, 0.f, 0.f};
    bf16x8 At[4][2], B0[2][2], B1[2][2];
    const char* cA = (const char*)cur.A + (size_t)cur.pm * tstep; const char* cB = (const char*)cur.Bt + (size_t)cur.pn * tstep;
    S.a_ready(cur);
    PG8_STAGE(PG8_SB(0, 0), cB, voffB); PG8_STAGE(PG8_SA(0, 0), cA, voffA); PG8_STAGE(PG8_SB(0, 1), cB + hstep, voffB); PG8_STAGE(PG8_SA(0, 1), cA + hstep, voffA);
    if (wr == 1) PG8_BAR;
    PG8_WAIT_V(4); PG8_BAR;
    PG8_STAGE(PG8_SB(1, 0), cB + kstep, voffB); PG8_STAGE(PG8_SA(1, 0), cA + kstep, voffA); PG8_STAGE(PG8_SB(1, 1), cB + hstep + kstep, voffB);
    PG8_WAIT_V(6); PG8_BAR;
    for (;;) {
        const bool has_next = S.next(ui + 1, nxt);
        const int nK = has_next ? nxt.K : K; const size_t nhstep = (size_t)HALF * nK * 2;
#pragma unroll
        for (int i = 0; i < 2; ++i) { int R, C; stage_rc(tid * 16 + i * 8192, R, C); const int Rb = Epi::PERM ? ((R & ~31) + perm32(R & 31)) : R;
            nvoffA[i] = (unsigned)(R * nK + C) * 2u; nvoffB[i] = (unsigned)(Rb * nK + C) * 2u; }
        const char* nA = has_next ? (const char*)nxt.A + (size_t)nxt.pm * (2 * nhstep) : cA; const char* nB = has_next ? (const char*)nxt.Bt + (size_t)nxt.pn * (2 * nhstep) : cB;
        for (int t = 0; t < nt; t += 2) {
            const bool last = (t == nt - 2);
            const char* a1 = cA + (size_t)(t + 1) * kstep;
            const char* a2 = last ? nA : cA + (size_t)(t + 2) * kstep; const char* b2 = last ? nB : cB + (size_t)(t + 2) * kstep;
            const char* a3 = a2 + kstep; const char* b3 = b2 + kstep;
            const size_t hs2 = last ? nhstep : hstep;
            if (last && has_next) S.a_ready(nxt);
            PG8_LDB(B0, 0, 0); PG8_SCHED; PG8_LDA(At, 0, 0); PG8_STAGE(PG8_SA(1, 1), a1 + hstep, voffA);
            if (last) {
#pragma unroll
                for (int i = 0; i < 2; ++i) { voffA[i] = nvoffA[i]; voffB[i] = nvoffB[i]; } }
            PG8_WAIT_L(8); PG8_BAR; PG8_WAIT_L(0); PG8_MMA(0, 0, At, B0); PG8_BAR; PG8_SCHED;
            PG8_LDB(B1, 0, 1); PG8_STAGE(PG8_SB(0, 0), b2, voffB);
            PG8_BAR; PG8_WAIT_L(0); PG8_MMA(0, 1, At, B1); PG8_BAR;
            PG8_LDA(At, 0, 1); PG8_STAGE(PG8_SA(0, 0), a2, voffA);
            PG8_BAR; PG8_WAIT_L(0); PG8_MMA(1, 0, At, B0); PG8_BAR; PG8_SCHED;
            PG8_STAGE(PG8_SB(0, 1), b2 + hs2, voffB);
            PG8_WAIT_V(6); PG8_BAR; PG8_MMA(1, 1, At, B1); PG8_BAR;
            PG8_LDB(B0, 1, 0); PG8_SCHED; PG8_LDA(At, 1, 0); PG8_STAGE(PG8_SA(0, 1), a2 + hs2, voffA);
            PG8_WAIT_L(8); PG8_BAR; PG8_WAIT_L(0); PG8_MMA(0, 0, At, B0); PG8_BAR; PG8_SCHED;
            PG8_LDB(B1, 1, 1); PG8_STAGE(PG8_SB(1, 0), b3, voffB);
            PG8_BAR; PG8_WAIT_L(0); PG8_MMA(0, 1, At, B1); PG8_BAR;
            PG8_LDA(At, 1, 1); PG8_STAGE(PG8_SA(1, 0), a3, voffA);
            PG8_BAR; PG8_WAIT_L(0); PG8_MMA(1, 0, At, B0); PG8_BAR; PG8_SCHED;
            PG8_STAGE(PG8_SB(1, 1), b3 + hs2, voffB);
            PG8_WAIT_V(6); PG8_BAR; PG8_MMA(1, 1, At, B1); PG8_BAR;
        }
        if constexpr (!Epi::AFTER_DRAIN) { E(acc, cur, wr, wc, fr, fq); S.done(cur); }
        if (!has_next) break;
#pragma unroll
        for (int a = 0; a < 2; ++a)
#pragma unroll
            for (int b = 0; b < 2; ++b)
#pragma unroll
                for (int m = 0; m < 4; ++m)
#pragma unroll
                    for (int n = 0; n < 2; ++n) acc[a][b][m][n] = (f32x4){0.f, 0.f, 0.f, 0.f};
        cur = nxt; cA = nA; cB = nB; ++ui; K = nK; nt = K / BK; hstep = nhstep; tstep = 2 * hstep;
    }
    PG8_WAIT_V(0);
    if (wr == 0) PG8_BAR;
    PG8_BAR;
    if constexpr (Epi::AFTER_DRAIN) { E.fused(acc, cur, wr, wc, fr, fq, lds, wid, lane); S.done(cur); }
#undef PG8_SA
#undef PG8_SB
#undef PG8_STAGE
#undef PG8_LDA
#undef PG8_LDB
#undef PG8_MMA
#undef PG8_WAIT_V
#undef PG8_WAIT_L
#undef PG8_BAR
#undef PG8_SCHED
}

struct P5Order {
    Unit t; const bf16_t* xb; const bf16_t* Wg; const bf16_t* br; const bf16_t* Wb; size_t brs;
    __device__ __forceinline__ bool next(int i, UnitX& u) const {
        if (i >= 8) return false;
        const int kb = i >> 1; u.pm = t.pm; u.pn = t.pn; u.kb = kb; u.kind = i & 1;
        if ((i & 1) == 0) { u.A = xb; u.Bt = Wg + (size_t)kb * 1024 * 1024; u.K = 1024; }
        else { u.A = br + (size_t)kb * brs; u.Bt = Wb + (size_t)kb * 1024 * 512; u.K = 512; }
        return true;
    }
    __device__ __forceinline__ void a_ready(const UnitX&) const {}
    __device__ __forceinline__ void done(const UnitX&) const {}
};
struct EpiP5 {
    static constexpr bool PERM = true, AFTER_DRAIN = false;
    const float* ss; bf16_t* gates; float* mrg; bf16_t* mb;
    __device__ __forceinline__ void operator()(const f32x4 (&acc)[2][2][4][2], const UnitX& u, int wr, int wc, int fr, int fq) const {
        const int row0 = u.pm * BM + wr * 64 + fr, col0 = u.pn * BM + wc * 32 + 8 * fq, kb = u.kb;
        if (u.kind == 0) {
#pragma unroll
            for (int ai = 0; ai < 2; ++ai)
#pragma unroll
                for (int m = 0; m < 4; ++m) {
                    const int row = row0 + ai * HALF + m * 16;
#pragma unroll
                    for (int bj = 0; bj < 2; ++bj) {
                        f32x4 v0 = acc[ai][bj][m][0], v1 = acc[ai][bj][m][1];
#pragma unroll
                        for (int j = 0; j < 4; ++j) { v0[j] = sigm(v0[j]); v1[j] = sigm(v1[j]); }
                        *(u32x4*)(gates + (size_t)row * 1024 + col0 + bj * HALF) = pack8(v0, v1);
                    }
                }
        } else {
#pragma unroll
            for (int ai = 0; ai < 2; ++ai)
#pragma unroll
                for (int m = 0; m < 4; ++m) {
                    const int row = row0 + ai * HALF + m * 16;
#pragma unroll
                    for (int bj = 0; bj < 2; ++bj) {
                        const size_t idx = (size_t)row * 1024 + col0 + bj * HALF;
                        f32x4 g0, g1; unpack8(*(const u32x4*)(gates + idx), g0, g1);
                        f32x4 m0 = {0.f, 0.f, 0.f, 0.f}, m1 = {0.f, 0.f, 0.f, 0.f};
                        if (kb > 0) { m0 = *(const f32x4*)(mrg + idx); m1 = *(const f32x4*)(mrg + idx + 4); }
                        m0 += g0 * acc[ai][bj][m][0]; m1 += g1 * acc[ai][bj][m][1];
                        if (kb < 3) { *(f32x4*)(mrg + idx) = m0; *(f32x4*)(mrg + idx + 4) = m1; }
                        else *(u32x4*)(mb + idx) = pack8(m0, m1);
                    }
                }
        }
    }
};
struct P10Order {
    Unit t; const bf16_t* pb; const bf16_t* Wp; const bf16_t* xb; const bf16_t* Wg;
    __device__ __forceinline__ bool next(int i, UnitX& u) const {
        if (i >= 2) return false;
        u.pm = t.pm; u.pn = t.pn; u.kb = 0; u.kind = i;
        if (i == 0) { u.A = pb; u.Bt = Wp; u.K = 256; } else { u.A = xb; u.Bt = Wg; u.K = 1024; }
        return true;
    }
    __device__ __forceinline__ void a_ready(const UnitX&) const {}
    __device__ __forceinline__ void done(const UnitX&) const {}
};
struct EpiP10 {
    static constexpr bool PERM = true, AFTER_DRAIN = false;
    const float* ss; bf16_t* pp; float* x; int s;
    __device__ __forceinline__ void operator()(const f32x4 (&acc)[2][2][4][2], const UnitX& u, int wr, int wc, int fr, int fq) const {
        const int row0 = u.pm * BM + wr * 64 + fr, col0 = u.pn * BM + wc * 32 + 8 * fq;
#pragma unroll
        for (int ai = 0; ai < 2; ++ai)
#pragma unroll
            for (int m = 0; m < 4; ++m) {
                const int row = row0 + ai * HALF + m * 16;
                if (u.kind == 0) {
#pragma unroll
                    for (int bj = 0; bj < 2; ++bj) *(u32x4*)(pp + (size_t)row * 1024 + col0 + bj * HALF) = pack8(acc[ai][bj][m][0], acc[ai][bj][m][1]);
                } else {
                    const size_t rowg = (size_t)((row >> 11) * 4096 + s * 2048 + (row & 2047));
                    const float rs = rsqrtf(ss[row] * (1.0f / 1024.0f) + 1e-6f);
#pragma unroll
                    for (int bj = 0; bj < 2; ++bj) {
                        const size_t gi = rowg * 1024 + col0 + bj * HALF;
                        f32x4 p0, p1; unpack8(*(const u32x4*)(pp + (size_t)row * 1024 + col0 + bj * HALF), p0, p1);
                        f32x4 x0 = *(const f32x4*)(x + gi), x1 = *(const f32x4*)(x + gi + 4);
#pragma unroll
                        for (int j = 0; j < 4; ++j) { x0[j] += p0[j] * sigm(acc[ai][bj][m][0][j] * rs); x1[j] += p1[j] * sigm(acc[ai][bj][m][1][j] * rs); }
                        *(f32x4*)(x + gi) = x0; *(f32x4*)(x + gi + 4) = x1;
                    }
                }
            }
    }
};

#define XB_TMO      128
#define XB_XCNT(j)  (256  + 64 * (j))
#define XB_XSUB(j)  (1280 + 64 * (j))
#define XB_XGEN(j)  (2304 + 64 * (j))
#define XB_TOP      3328
#define XB_TOPGEN   3392
#define XCD_BAR_WORDS 3456
#define XB_SPIN_CAP (1u << 18)
#define LAS PG8_LAS

__device__ __forceinline__ unsigned xb_ld(unsigned* p)              { return __hip_atomic_load(p, __ATOMIC_RELAXED, __HIP_MEMORY_SCOPE_AGENT); }
__device__ __forceinline__ unsigned xb_add(unsigned* p, unsigned v) { return __hip_atomic_fetch_add(p, v, __ATOMIC_RELAXED, __HIP_MEMORY_SCOPE_AGENT); }
__device__ __forceinline__ unsigned xb_xcc_id() { return (unsigned)__builtin_amdgcn_s_getreg((3 << 11) | 20) & 0xFu; }
#define XB_SPIN(cond, bar) do { unsigned _sp = 0; while (cond) { __builtin_amdgcn_s_sleep(1); \
    if ((++_sp & 255u) == 0u) { if (xb_ld(&(bar)[XB_TMO])) break; if (_sp > XB_SPIN_CAP) { atomicAdd(&(bar)[XB_TMO], 1u); break; } } } } while (0)

struct XcdBarrier {
    unsigned* bar; unsigned x;
    volatile LAS unsigned* st;
};

__device__ __forceinline__ XcdBarrier xcd_barrier_post(unsigned* bar, volatile LAS unsigned* st) {
    XcdBarrier b; b.bar = bar; b.x = xb_xcc_id(); b.st = st;
    if (threadIdx.x == 0) (void)xb_add(&bar[XB_XCNT(b.x)], 1u);
    return b;
}
__device__ __forceinline__ void xcd_barrier_complete(unsigned* bar, unsigned x, unsigned& nloc, unsigned& nx) {
    const unsigned G = gridDim.x * gridDim.y * gridDim.z;
    unsigned sum, cnt, mine, sp = 0u;
    for (;;) {
        sum = 0u; cnt = 0u; mine = 0u;
#pragma unroll
        for (unsigned j = 0; j < 16; ++j) { const unsigned c = xb_ld(&bar[XB_XCNT(j)]); sum += c; cnt += (c > 0u) ? 1u : 0u; mine = (j == x) ? c : mine; }
        if (sum == G) break;
        __builtin_amdgcn_s_sleep(1);
        if ((++sp & 255u) == 0u) { if (xb_ld(&bar[XB_TMO])) break; if (sp > XB_SPIN_CAP) { atomicAdd(&bar[XB_TMO], 1u); break; } }
    }
    nloc = mine > 0u ? mine : 1u; nx = cnt > 0u ? cnt : 1u;
}

__device__ __forceinline__ void xcd_barrier(const XcdBarrier& b) {
    asm volatile("s_waitcnt vmcnt(0)" ::: "memory");
    __syncthreads();
    if (threadIdx.x == 0) {
        unsigned* bar = b.bar;
        __builtin_amdgcn_s_waitcnt(0);
        unsigned nloc = b.st[0], nx = b.st[1];
        if (nloc == 0u) { xcd_barrier_complete(bar, b.x, nloc, nx); b.st[0] = nloc; b.st[1] = nx; }
        const unsigned old = xb_add(&bar[XB_XSUB(b.x)], 1u);
        const unsigned gen = old / nloc;
        if (old + 1u == (gen + 1u) * nloc) {
            __builtin_amdgcn_fence(__ATOMIC_RELEASE, "agent");
            asm volatile("s_waitcnt vmcnt(0)" ::: "memory");
            const unsigned og = xb_add(&bar[XB_TOP], 1u);
            const unsigned tg = og / nx;
            if (og + 1u == (tg + 1u) * nx) xb_add(&bar[XB_TOPGEN], 1u);
            else XB_SPIN(xb_ld(&bar[XB_TOPGEN]) == tg, bar);
            __builtin_amdgcn_fence(__ATOMIC_ACQUIRE, "agent");
            xb_add(&bar[XB_XGEN(b.x)], 1u);
            asm volatile("s_waitcnt vmcnt(0)" ::: "memory");
        } else {
            XB_SPIN(xb_ld(&bar[XB_XGEN(b.x)]) == gen, bar);
            __builtin_amdgcn_fence(__ATOMIC_ACQUIRE, "agent");
            asm volatile("s_waitcnt vmcnt(0)" ::: "memory");
        }
    }
    __syncthreads();
}


template <int OFF> __device__ __forceinline__ const float* karg_ptr() { const __attribute__((address_space(1))) float* r; asm volatile("s_load_dwordx2 %0, %1, %2\n\ts_waitcnt lgkmcnt(0)" : "=s"(r) : "s"(__builtin_amdgcn_kernarg_segment_ptr()), "n"(OFF) : "memory"); return (const float*)r; }
#define IN(i) (karg_ptr<(i) * 8>())
#define OUTP() ((float*)karg_ptr<34 * 8>())
#define WSP() ((unsigned char*)karg_ptr<35 * 8>())
template <class T> __device__ __forceinline__ T launder_s(T v) { asm volatile("" : "+s"(v)); return v; }
struct Params { const float* in[34]; float* out; unsigned char* ws; };
constexpr size_t MiB = 1ull << 20;
constexpr size_t WL_BYTES = 43 * MiB;
constexpr size_t oWin = 0, oWb = 9175040, oWo = 11272192, oWup = 12320768, oWd = 18087936, oWp = 20971520, oWg = 21233664, oPw = 22282240, oW2 = 22347776, oA2 = 22380544, oG2 = 22413312;
constexpr size_t XB_OFF = 86 * MiB, PB_OFF = 118 * MiB, SS_OFF = 126 * MiB, SAVEA_OFF = 126 * MiB + 256 * 1024, SAVEB_OFF = SAVEA_OFF + 128 * 1024, SAVEU_OFF = SAVEB_OFF + 32 * 1024,
                 C1_OFF = 127 * MiB, C2_OFF = C1_OFF + 512 * 1024, C3_OFF = 128 * MiB, RS_OFF = 129 * MiB, HS_OFF = 130 * MiB, ST_OFF = 132 * MiB;
constexpr size_t BAR_OFF = SS_OFF + 196608;
constexpr int MS = 16384;
struct Bufs {
    bf16_t* W; bf16_t* xb; bf16_t* pb; float* ss0; float* ss1; float* ss2; bf16_t* saveA; bf16_t* saveB; bf16_t* saveU; float* C1; float* C2; float* C3; float* RS; float* HS;
    bf16_t* bufA; bf16_t* bufB; bf16_t* bufC; bf16_t* bufD; float* Wf; bf16_t* KK; bf16_t* V; bf16_t* G; bf16_t* br;
    float* mrg; bf16_t* gates; bf16_t* mb; bf16_t* bufU; bf16_t* act; bf16_t* pp; bf16_t* St; float* DEC;
};
__device__ __forceinline__ Bufs make_bufs(unsigned char* ws, int l) {
    Bufs B; unsigned char* st = ws + ST_OFF;
    B.W = (bf16_t*)(ws + (size_t)l * WL_BYTES); B.xb = (bf16_t*)(ws + XB_OFF); B.pb = (bf16_t*)(ws + PB_OFF);
    B.ss0 = (float*)(ws + SS_OFF); B.ss1 = B.ss0 + MS; B.ss2 = B.ss1 + MS;
    B.saveA = (bf16_t*)(ws + SAVEA_OFF); B.saveB = (bf16_t*)(ws + SAVEB_OFF); B.saveU = (bf16_t*)(ws + SAVEU_OFF);
    B.C1 = (float*)(ws + C1_OFF); B.C2 = (float*)(ws + C2_OFF); B.C3 = (float*)(ws + C3_OFF); B.RS = (float*)(ws + RS_OFF); B.HS = (float*)(ws + HS_OFF);
    B.bufA = (bf16_t*)(st); B.bufB = (bf16_t*)(st + 16 * MiB); B.bufC = (bf16_t*)(st + 72 * MiB); B.bufD = (bf16_t*)(st + 104 * MiB);
    B.Wf = (float*)(st + 152 * MiB); B.KK = (bf16_t*)(st + 184 * MiB)  ; B.V = (bf16_t*)(st + 248 * MiB); B.G = (bf16_t*)(st + 264 * MiB);
    B.br = (bf16_t*)(st + 280 * MiB);
    B.mrg = (float*)(st); B.gates = (bf16_t*)(st + 64 * MiB); B.mb = (bf16_t*)(st + 96 * MiB);
    B.bufU = (bf16_t*)(st); B.act = (bf16_t*)(st + 176 * MiB); B.pp = (bf16_t*)(st + 280 * MiB);
    B.St = (bf16_t*)(st + 344 * MiB); B.DEC = (float*)(st + 376 * MiB);
    return B;
}
constexpr size_t VEC_STRIDE = (size_t)MS * 512;

__device__ __forceinline__ f32x4 mma_tile(const bf16_t* A, int lda, const bf16_t* Bt, int ldb, int K, int lane) {
    f32x4 acc = {0.f, 0.f, 0.f, 0.f};
    const bf16_t* ap = A + (lane & 15) * lda + (lane >> 4) * 8;
    const bf16_t* bp = Bt + (lane & 15) * ldb + (lane >> 4) * 8;
    for (int k = 0; k < K; k += 32) {
        const bf16x8 a = *(const bf16x8*)(ap + k), b = *(const bf16x8*)(bp + k);
        acc = __builtin_amdgcn_mfma_f32_16x16x32_bf16(a, b, acc, 0, 0, 0);
    }
    return acc;
}

template <int NK> __device__ __forceinline__ void load_bfrag(bf16x8 (&f)[NK], const bf16_t* Bt, int ldb, int lane) {
    const bf16_t* bp = Bt + (lane & 15) * ldb + (lane >> 4) * 8;
#pragma unroll
    for (int k = 0; k < NK; ++k) f[k] = *(const bf16x8*)(bp + k * 32);
}
template <int NK> __device__ __forceinline__ f32x4 mma_tile_pre(const bf16_t* A, int lda, const bf16x8 (&f)[NK], int lane) {
    f32x4 acc = {0.f, 0.f, 0.f, 0.f};
    const bf16_t* ap = A + (lane & 15) * lda + (lane >> 4) * 8;
#pragma unroll
    for (int k = 0; k < NK; ++k) acc = __builtin_amdgcn_mfma_f32_16x16x32_bf16(*(const bf16x8*)(ap + k * 32), f[k], acc, 0, 0, 0);
    return acc;
}

template <bool SA, bool SB> __device__ __forceinline__ f32x4 mma_tile64(const bf16_t* A, int ra0, const bf16_t* Bt, int rb0, int lane) {
    f32x4 acc = {0.f, 0.f, 0.f, 0.f};
    const int ra = ra0 + (lane & 15), rb = rb0 + (lane & 15), q = lane >> 4;
    const int sa = SA ? ((ra >> 3) & 7) : 0, sb = SB ? ((rb >> 3) & 7) : 0;
#pragma unroll
    for (int kk = 0; kk < 2; ++kk) {
        const bf16x8 a = *(const bf16x8*)(A + ra * 72 + (((kk * 4 + q) ^ sa) << 3));
        const bf16x8 b = *(const bf16x8*)(Bt + rb * 72 + (((kk * 4 + q) ^ sb) << 3));
        acc = __builtin_amdgcn_mfma_f32_16x16x32_bf16(a, b, acc, 0, 0, 0);
    }
    return acc;
}

__device__ __forceinline__ void tconv(const float* __restrict__ src, bf16_t* __restrict__ dst, int K, int N, const float* __restrict__ scale, float* tile, int& rot) {
    const int tk = K >> 6, tn = N >> 6, nt = tk * tn, G = gridDim.x;
    const int tid = tid_v(), lr = tid >> 4, lc = (tid & 15) * 4;
    const int sn = tid >> 3, sk = (tid & 7) * 8;
    int t = (int)((bid_s() + G - (rot % G)) % G);
    f32x4 v0, v1;
    if (t < nt) { const int kt = t / tn, k0 = kt << 6, n0 = (t - kt * tn) << 6; v0 = *(const f32x4*)(src + (size_t)(k0 + lr) * N + n0 + lc); v1 = *(const f32x4*)(src + (size_t)(k0 + lr + 32) * N + n0 + lc); }
    for (; t < nt; t += G) {
        const int kt = t / tn, k0 = kt << 6, n0 = (t - kt * tn) << 6;
        __syncthreads();
#pragma unroll
        for (int j = 0; j < 4; ++j) { tile[lr * 65 + lc + j] = v0[j]; tile[(lr + 32) * 65 + lc + j] = v1[j]; }
        const int t2 = t + G;
        if (t2 < nt) { const int kt2 = t2 / tn, k2 = kt2 << 6, n2 = (t2 - kt2 * tn) << 6; v0 = *(const f32x4*)(src + (size_t)(k2 + lr) * N + n2 + lc); v1 = *(const f32x4*)(src + (size_t)(k2 + lr + 32) * N + n2 + lc); }
        __syncthreads();
        f32x4 a, bb;
#pragma unroll
        for (int j = 0; j < 4; ++j) { a[j] = tile[(sk + j) * 65 + sn]; bb[j] = tile[(sk + 4 + j) * 65 + sn]; }
        if (scale) { a *= *(const f32x4*)(scale + k0 + sk); bb *= *(const f32x4*)(scale + k0 + sk + 4); }
        *(u32x4*)(dst + (size_t)(n0 + sn) * K + k0 + sk) = pack8(a, bb);
    }
    rot += nt;
}
__device__ __forceinline__ void phase0(unsigned char* shm) {
    float* tile = (float*)shm; int rot = 0;
    for (int l = 0; l < 2; ++l) {
        bf16_t* W = (bf16_t*)(WSP() + (size_t)l * WL_BYTES);
        tconv(IN(3) + (size_t)l * 1024 * 8960, W + oWin, 1024, 8960, IN(2) + l * 1024, tile, rot);
        for (int k = 0; k < 4; ++k) tconv(IN(23) + (size_t)(l * 4 + k) * 512 * 1024, W + oWb + (size_t)k * 1024 * 512, 512, 1024, nullptr, tile, rot);
        tconv(IN(24) + (size_t)l * 1024 * 1024, W + oWo, 1024, 1024, nullptr, tile, rot);
        tconv(IN(26) + (size_t)l * 1024 * 5632, W + oWup, 1024, 5632, IN(25) + l * 1024, tile, rot);
        tconv(IN(29) + (size_t)l * 2816 * 1024, W + oWd, 2816, 1024, nullptr, tile, rot);
        tconv(IN(31) + (size_t)l * 256 * 1024, W + oWp, 256, 1024, nullptr, tile, rot);
        tconv(IN(32) + (size_t)l * 1024 * 1024, W + oWg, 1024, 1024, IN(30) + l * 1024, tile, rot);
        for (int g = 0; g < 4; ++g) tconv(IN(4) + (size_t)(l * 4 + g) * 128 * 128, W + oPw + (size_t)g * 16384, 128, 128, nullptr, tile, rot);
        tconv(IN(8) + (size_t)l * 64 * 512, W + oW2, 64, 512, nullptr, tile, rot);
        tconv(IN(10) + (size_t)l * 64 * 512, W + oA2, 64, 512, nullptr, tile, rot);
        tconv(IN(11) + (size_t)l * 128 * 512, W + oG2, 128, 512, nullptr, tile, rot);
    }
    __syncthreads();
}

__device__ __forceinline__ void phaseX(int l, int s) {
    const Bufs B = make_bufs(WSP(), l);
    const float* xin = l == 0 ? IN(0) : OUTP();
    const float* pin = IN(1) + (size_t)l * 32768 * 256;
    const int lane = tid_v() & 63, gw = bid_s() * 8 + (tid_v() >> 6);
    for (int mb = gw; mb < MS; mb += 4096) {
        f32x4 v[2][4], pv[2]; size_t rg[2];
#pragma unroll
        for (int u = 0; u < 2; ++u) { const int m = mb + 2048 * u; rg[u] = (size_t)((m >> 11) * 4096 + s * 2048 + (m & 2047)); const f32x4* xr = (const f32x4*)(xin + rg[u] * 1024);
#pragma unroll
            for (int i = 0; i < 4; ++i) v[u][i] = xr[lane + 64 * i];
            pv[u] = *(const f32x4*)(pin + rg[u] * 256 + lane * 4); }
#pragma unroll
        for (int u = 0; u < 2; ++u) { const int m = mb + 2048 * u; float sum = 0.f;
#pragma unroll
            for (int i = 0; i < 4; ++i) { const f32x4 x = v[u][i]; sum += x[0] * x[0] + x[1] * x[1] + x[2] * x[2] + x[3] * x[3]; }
            sum = wsum(sum);
            const float rs = rsqrtf(sum * (1.0f / 1024.0f) + 1e-6f);
#pragma unroll
            for (int i = 0; i < 4; ++i) { const f32x4 x = v[u][i] * rs;
                u32x2 w; w.x = cvt_pk_bf16(x[0], x[1]); w.y = cvt_pk_bf16(x[2], x[3]); *(u32x2*)(B.xb + (size_t)m * 1024 + (lane + 64 * i) * 4) = w; }
            if (lane == 0) { B.ss1[m] = 0.f; B.ss2[m] = 0.f; }
            u32x2 w; w.x = cvt_pk_bf16(pv[u][0], pv[u][1]); w.y = cvt_pk_bf16(pv[u][2], pv[u][3]); *(u32x2*)(B.pb + (size_t)m * 256 + lane * 4) = w; }
    }
}

struct PoolRegs { u32x4 rv[3]; };
__device__ __forceinline__ PoolRegs pool_issue(const Bufs& B, int s, int it, int tid) {
    PoolRegs R; const int tt = it >> 2, g = it & 3, m0 = tt * 64, b = m0 >> 11, tl0 = m0 & 2047;
#pragma unroll
    for (int i = 0; i < 3; ++i) {
        int idx = tid + 512 * i; idx = idx < 1280 ? idx : 1279;
        const int r = idx >> 4, c8 = (idx & 15) * 8, tl = tl0 - 16 + r;
        const bf16_t* src = tl >= 0 ? B.bufA + (size_t)(b * 2048 + tl) * 512 + g * 128 + c8 : B.saveA + (size_t)(b * 16 + 16 + tl) * 512 + g * 128 + c8;
        R.rv[i] = *(const u32x4*)src;
        if (tl < 0 && s == 0) R.rv[i] = (u32x4){0u, 0u, 0u, 0u};
    }
    return R;
}
__device__ __forceinline__ void pool_item(const Bufs& B, int l, int s, int it, unsigned char* shm, const PoolRegs& R) {
    const int tid = tid_v(), lane = tid & 63, wid = tid >> 6;
    const int tt = it >> 2, g = it & 3, m0 = tt * 64, b = m0 >> 11, tl0 = m0 & 2047;
    float* raw = (float*)shm;
    bf16_t* dA = (bf16_t*)(shm + 40960);
    bf16x8 pf[4]; load_bfrag<4>(pf, B.W + oPw + (size_t)g * 16384 + wid * 16 * 128, 128, lane);
    __syncthreads();
#pragma unroll
    for (int i = 0; i < 3; ++i) {
        const int idx = tid + 512 * i;
        if (idx < 1280) {
            const int r = idx >> 4, c8 = (idx & 15) * 8, tl = tl0 - 16 + r;
            f32x4 a, bb; unpack8(R.rv[i], a, bb);
            *(f32x4*)(raw + r * 128 + c8) = a; *(f32x4*)(raw + r * 128 + c8 + 4) = bb;
            if (s == 0 && tl >= 2032) *(u32x4*)(B.saveA + (size_t)(b * 16 + tl - 2032) * 512 + g * 128 + c8) = R.rv[i];
        }
    }
    __syncthreads();
    {
        const int win = 2 << g, c = tid & 127, t0 = (tid >> 7) * 16;
        float run = 0.f;
        for (int j = 1; j < win; ++j) run += raw[(16 + t0 - j) * 128 + c];
#pragma unroll 4
        for (int q = 0; q < 16; ++q) {
            const int t = t0 + q, tg = s * 2048 + tl0 + t;
            const float cur = raw[(16 + t) * 128 + c];
            run += cur;
            const int cnt = (tg + 1) < win ? (tg + 1) : win;
            dA[t * 136 + c] = f2bf(run / (float)cnt - cur);
            run -= raw[(16 + t - win + 1) * 128 + c];
        }
    }
    __syncthreads();
    const float* scale = IN(5) + l * 512 + g * 128;
    for (int tile = wid; tile < 32; tile += 8) {
        const int tm = tile >> 3, tn = tile & 7;
        const f32x4 acc = mma_tile_pre<4>(dA + tm * 16 * 136, 136, pf, lane);
        const int col = tn * 16 + (lane & 15);
        const float sc = scale[col];
#pragma unroll
        for (int j = 0; j < 4; ++j) { const int row = tm * 16 + (lane >> 4) * 4 + j; B.br[(size_t)(m0 + row) * 512 + g * 128 + col] = f2bf(acc[j] * sc); }
    }
}

__device__ __forceinline__ void sg_item(const Bufs& B, int l, int s, int it, unsigned char* shm) {
    const int tid = tid_v(), lane = tid & 63, wid = tid >> 6;
    const int ch = it >> 2, g = it & 3, m0 = ch * 128;
    bf16_t* Wm = (bf16_t*)shm;
    bf16_t* VnT = (bf16_t*)(shm + 34816);
    bf16_t* uS = (bf16_t*)(shm + 69632);
    const int t = tid >> 2, part = tid & 3, cl0 = part * 32, cg0 = g * 128 + cl0;
    u32x4 sv[16], vq[4], uv[4]; f32x4 wv[8];
    {
        const u32x4* vp = (const u32x4*)(B.bufC + (size_t)(m0 + t) * 1024 + 512 + part * 128);
#pragma unroll
        for (int i = 0; i < 16; ++i) sv[i] = vp[i];
        const u32x4* vqp = (const u32x4*)(B.bufC + (size_t)(m0 + t) * 1024 + 512 + cg0);
#pragma unroll
        for (int i = 0; i < 4; ++i) vq[i] = vqp[i];
        const float* sw = IN(19) + (size_t)(l * 4 + g) * 16384;
#pragma unroll
        for (int i = 0; i < 8; ++i) wv[i] = *(const f32x4*)(sw + (tid + 512 * i) * 4);
    }
    __syncthreads();
    {
        float sum = 0.f, sq = 0.f;
#pragma unroll
        for (int i = 0; i < 16; ++i) { f32x4 a, bb; unpack8(sv[i], a, bb);
            sum += (a[0] + a[1]) + (a[2] + a[3]) + (bb[0] + bb[1]) + (bb[2] + bb[3]);
            sq += a[0] * a[0] + a[1] * a[1] + a[2] * a[2] + a[3] * a[3] + bb[0] * bb[0] + bb[1] * bb[1] + bb[2] * bb[2] + bb[3] * bb[3]; }
        sum += __shfl_xor(sum, 1); sum += __shfl_xor(sum, 2); sq += __shfl_xor(sq, 1); sq += __shfl_xor(sq, 2);
        const float mean = sum * (1.0f / 512.0f), var = sq * (1.0f / 512.0f) - mean * mean, rstd = rsqrtf(fmaxf(var, 0.f) + 1e-5f);
#pragma unroll
        for (int i = 0; i < 4; ++i) { const int idx = tid + 512 * i; uv[i] = *(const u32x4*)(B.bufC + (size_t)(m0 + (idx >> 4)) * 1024 + g * 128 + (idx & 15) * 8); }
        const float* lnw = IN(17) + l * 512 + cg0; const float* lnb = IN(18) + l * 512 + cg0;
#pragma unroll
        for (int i = 0; i < 4; ++i) { f32x4 a, bb; unpack8(vq[i], a, bb);
#pragma unroll
            for (int j = 0; j < 4; ++j) {
                VnT[(cl0 + i * 8 + j) * 136 + t] = f2bf((a[j] - mean) * rstd * lnw[i * 8 + j] + lnb[i * 8 + j]);
                VnT[(cl0 + i * 8 + 4 + j) * 136 + t] = f2bf((bb[j] - mean) * rstd * lnw[i * 8 + 4 + j] + lnb[i * 8 + 4 + j]); } }
#pragma unroll
        for (int i = 0; i < 8; ++i) { const int idx = tid + 512 * i, tt = idx >> 5, s4 = (idx & 31) * 4;
            u32x2 w; w.x = cvt_pk_bf16(s4 <= tt ? wv[i][0] : 0.f, s4 + 1 <= tt ? wv[i][1] : 0.f); w.y = cvt_pk_bf16(s4 + 2 <= tt ? wv[i][2] : 0.f, s4 + 3 <= tt ? wv[i][3] : 0.f);
            *(u32x2*)(Wm + tt * 136 + s4) = w; }
#pragma unroll
        for (int i = 0; i < 4; ++i) { const int idx = tid + 512 * i; *(u32x4*)(uS + (idx >> 4) * 136 + (idx & 15) * 8) = uv[i]; }
    }
    __syncthreads();
    const float* sb = IN(20) + (l * 4 + g) * 128;
    for (int tile = wid; tile < 64; tile += 8) {
        const int tm = tile >> 3, tn = tile & 7;
        const int Kc = ((tm * 16 + 16 + 31) >> 5) << 5;
        const f32x4 acc = mma_tile(Wm + tm * 16 * 136, 136, VnT + tn * 16 * 136, 136, Kc, lane);
        const int c = tn * 16 + (lane & 15);
#pragma unroll
        for (int j = 0; j < 4; ++j) { const int tq = tm * 16 + (lane >> 4) * 4 + j;
            B.br[2 * VEC_STRIDE + (size_t)(m0 + tq) * 512 + g * 128 + c] = f2bf(bf2f(uS[tq * 136 + c]) * (acc[j] + sb[tq])); }
    }
}

__device__ __forceinline__ float rsum8(float v) { v += dppf<0xB1>(v); v += dppf<0x4E>(v); v += dppf<0x141>(v); return v; }
struct PrepRegs { u32x4 cw, pw; };
__device__ __forceinline__ PrepRegs prep_issue(const Bufs& B, int s, int it, int tid) {
    PrepRegs R; const int m0 = it * 16, b = m0 >> 11, tl0 = m0 & 2047;
    const bf16_t* sB = B.saveB + b * 1792; const u32x4 zero4 = {0u, 0u, 0u, 0u};
    { const int t = tid >> 5, cg = tid & 31, c0 = 1536 + cg * 8, m = m0 + t, tl = tl0 + t;
      R.cw = *(const u32x4*)(B.bufB + (size_t)m * 1792 + c0);
      R.pw = tl > 0 ? *(const u32x4*)(B.bufB + (size_t)(m - 1) * 1792 + c0) : (s == 1 ? *(const u32x4*)(sB + c0) : zero4); }
    return R;
}
__device__ __forceinline__ void prep_item(const Bufs& B, int l, int s, int it, unsigned char* shm, const bf16x8 (&w2f)[4][2], const bf16x8 (&a2f)[4][2], const PrepRegs& R) {
    const int tid = tid_v(), lane = tid & 63, wid = tid >> 6;
    const int m0 = it * 16, b = m0 >> 11, tl0 = m0 & 2047;
    bf16_t* Lw = (bf16_t*)shm;
    bf16_t* La = (bf16_t*)(shm + 2304);
    bf16_t* Lg = (bf16_t*)(shm + 4608);
    float* Aa = (float*)(shm + 9216);
    float* Dd = (float*)(shm + 9216 + 32768);
    const float* mu = IN(6) + l * 1792;
    const bf16_t* sB = B.saveB + b * 1792;
    const u32x4 zero4 = {0u, 0u, 0u, 0u};
    u32x4 c3w[2][3], p3w[2][3];
#pragma unroll
    for (int tt = 0; tt < 2; ++tt) { const int t = wid + 8 * tt, m = m0 + t, tl = tl0 + t; const bf16_t* cr = B.bufB + (size_t)m * 1792 + lane * 8;
#pragma unroll
        for (int q = 0; q < 3; ++q) { c3w[tt][q] = *(const u32x4*)(cr + q * 512); p3w[tt][q] = tl > 0 ? *(const u32x4*)(cr - 1792 + q * 512) : (s == 1 ? *(const u32x4*)(sB + q * 512 + lane * 8) : zero4); } }
    __syncthreads();
    {
        const int t = tid >> 5, cg = tid & 31, c0 = 1536 + cg * 8;
        f32x4 c0v, c1v, p0v, p1v; unpack8(R.cw, c0v, c1v); unpack8(R.pw, p0v, p1v);
        const f32x4 m0v = *(const f32x4*)(mu + c0), m1v = *(const f32x4*)(mu + c0 + 4);
        f32x4 x0 = c0v + m0v * (p0v - c0v), x1 = c1v + m1v * (p1v - c1v);
        if (cg < 8) {
#pragma unroll
            for (int j = 0; j < 4; ++j) { x0[j] = 2.0f * sigm(2.0f * x0[j]) - 1.0f; x1[j] = 2.0f * sigm(2.0f * x1[j]) - 1.0f; }
            *(u32x4*)(Lw + t * 72 + cg * 8) = pack8(x0, x1);
        } else if (cg < 16) {
            *(u32x4*)(La + t * 72 + (cg - 8) * 8) = pack8(x0, x1);
        } else {
#pragma unroll
            for (int j = 0; j < 4; ++j) { x0[j] = sigm(x0[j]); x1[j] = sigm(x1[j]); }
            *(u32x4*)(Lg + t * 136 + (cg - 16) * 8) = pack8(x0, x1);
        }
    }
    __syncthreads();
    {
        const float* w0 = IN(7) + l * 512; const float* a0 = IN(9) + l * 512;
#pragma unroll
        for (int i = 0; i < 4; ++i) {
            const int tn = wid + 8 * i, c = tn * 16 + (lane & 15);
            bf16x8 g2f[4]; load_bfrag<4>(g2f, B.W + oG2 + tn * 16 * 128, 128, lane);
            f32x4 acc = mma_tile_pre<2>(Lw, 72, w2f[i], lane);
#pragma unroll
            for (int j = 0; j < 4; ++j) { const int t = (lane >> 4) * 4 + j; Dd[t * 512 + c] = __expf(-0.6065306597f * sigm(w0[c] + acc[j])); }
            acc = mma_tile_pre<2>(La, 72, a2f[i], lane);
#pragma unroll
            for (int j = 0; j < 4; ++j) { const int t = (lane >> 4) * 4 + j; Aa[t * 512 + c] = sigm(a0[c] + acc[j]); }
            acc = mma_tile_pre<4>(Lg, 136, g2f, lane);
#pragma unroll
            for (int j = 0; j < 4; ++j) { const int t = (lane >> 4) * 4 + j; B.G[(size_t)(m0 + t) * 512 + c] = f2bf(acc[j]); }
        }
    }
    __syncthreads();
    const float* kkp = IN(12) + l * 512; const float* kap = IN(13) + l * 512; const float* rkp = IN(14) + l * 512;
    const int c0 = lane * 8, h = lane >> 3;
#pragma unroll
    for (int tt = 0; tt < 2; ++tt) {
        const int t = wid + 8 * tt, m = m0 + t, tl = tl0 + t;
        const bf16_t* cr = B.bufB + (size_t)m * 1792;
        f32x4 r[2], k[2], v[2];
#pragma unroll
        for (int q = 0; q < 3; ++q) {
            f32x4 c0v, c1v, p0v, p1v; unpack8(c3w[tt][q], c0v, c1v); unpack8(p3w[tt][q], p0v, p1v);
            const f32x4 m0v = *(const f32x4*)(mu + q * 512 + c0), m1v = *(const f32x4*)(mu + q * 512 + c0 + 4);
            const f32x4 x0 = c0v + m0v * (p0v - c0v), x1 = c1v + m1v * (p1v - c1v);
            if (q == 0) { r[0] = x0; r[1] = x1; } else if (q == 1) { k[0] = x0; k[1] = x1; } else { v[0] = x0; v[1] = x1; }
        }
        f32x4 kk[2], kp[2], ka[2], wv[2], av[2];
        float n2 = 0.f, c2 = 0.f, c3 = 0.f;
#pragma unroll
        for (int e = 0; e < 2; ++e) {
            av[e] = *(const f32x4*)(Aa + t * 512 + c0 + 4 * e); wv[e] = *(const f32x4*)(Dd + t * 512 + c0 + 4 * e);
            const f32x4 kkw = *(const f32x4*)(kkp + c0 + 4 * e), kaw = *(const f32x4*)(kap + c0 + 4 * e), rkw = *(const f32x4*)(rkp + c0 + 4 * e);
            kk[e] = k[e] * kkw;
            kp[e] = k[e] * (1.0f + (av[e] - 1.0f) * kaw);
#pragma unroll
            for (int j = 0; j < 4; ++j) { n2 += kk[e][j] * kk[e][j]; c2 += kp[e][j] * r[e][j]; c3 += r[e][j] * kp[e][j] * rkw[j]; }
        }
        n2 = rsum8(n2); c2 = rsum8(c2); c3 = rsum8(c3);
        const float inv = 1.0f / fmaxf(sqrtf(n2), 1e-12f);
        float c1 = 0.f;
#pragma unroll
        for (int e = 0; e < 2; ++e) { kk[e] = kk[e] * inv; ka[e] = kk[e] * av[e];
#pragma unroll
            for (int j = 0; j < 4; ++j) c1 += ka[e][j] * r[e][j]; }
        c1 = rsum8(c1);
        const size_t o = (size_t)m * 512 + c0;
        *(f32x4*)(B.Wf + o) = wv[0]; *(f32x4*)(B.Wf + o + 4) = wv[1];
        *(u32x4*)(B.KK + o) = pack8(kk[0], kk[1]);
        *(u32x4*)(B.KK + VEC_STRIDE + o) = pack8(wv[0] * r[0], wv[1] * r[1]);
        *(u32x4*)(B.KK + 2 * VEC_STRIDE + o) = pack8(ka[0], ka[1]);
        *(u32x4*)(B.KK + 3 * VEC_STRIDE + o) = pack8(kp[0], kp[1]);
        *(u32x4*)(B.V + o) = pack8(v[0], v[1]);
        if ((lane & 7) == 0) { B.C1[m * 8 + h] = c1; B.C2[m * 8 + h] = c2; B.C3[m * 8 + h] = c3; }
    }
    if (s == 0 && tl0 + 16 == 2048) for (int c = tid; c < 1792; c += 512) B.saveB[b * 1792 + c] = B.bufB[(size_t)(b * 2048 + 2047) * 1792 + c];
}

__device__ __forceinline__ void hg_cum(const u32x4 (&ev)[2], int l, int h, const float* hlb, float* cumS, float* lbS, int tid) {
    __syncthreads();
    if (tid < 128) lbS[tid] = l == 0 ? 1.0f : 1.0f - sigm(hlb[512 + h * 128 + tid] - hlb[h * 128 + tid]);
    __syncthreads();
#pragma unroll
    for (int q = 0; q < 2; ++q) {
        const int idx = tid + 512 * q, t = idx >> 4, k8 = (idx & 15) * 8;
        f32x4 a, bb; unpack8(ev[q], a, bb);
        const f32x4 l0 = *(const f32x4*)(lbS + k8), l1 = *(const f32x4*)(lbS + k8 + 4);
#pragma unroll
        for (int j = 0; j < 4; ++j) { a[j] = __logf(fmaxf(1.0f - l0[j] * a[j], 1e-30f)); bb[j] = __logf(fmaxf(1.0f - l1[j] * bb[j], 1e-30f)); }
        *(f32x4*)(cumS + t * 128 + k8) = a; *(f32x4*)(cumS + t * 128 + k8 + 4) = bb;
    }
    __syncthreads();
    const int k = tid & 127, seg = tid >> 7;
    { float run = 0.f;
#pragma unroll
      for (int tt = 0; tt < 16; ++tt) { const int t = seg * 16 + tt; run += cumS[t * 128 + k]; cumS[t * 128 + k] = run; } }
    __syncthreads();
    float off = 0.f;
    for (int sp = 0; sp < seg; ++sp) off += cumS[(16 * sp + 15) * 128 + k];
    __syncthreads();
#pragma unroll
    for (int tt = 0; tt < 16; ++tt) cumS[(seg * 16 + tt) * 128 + k] += off;
    __syncthreads();
}

struct HgRegs { u32x4 ev[2], iv[2]; };
__device__ __forceinline__ HgRegs hgA_issue(const Bufs& B, int it, int tid) {
    HgRegs R; const int bh = it >> 5, ch = it & 31, b = bh >> 2, h = bh & 3, m0 = b * 2048 + ch * 64;
#pragma unroll
    for (int q = 0; q < 2; ++q) { const int idx = tid + 512 * q; const bf16_t* rowp = B.bufD + (size_t)(m0 + (idx >> 4)) * 1536 + h * 128 + (idx & 15) * 8; R.ev[q] = *(const u32x4*)(rowp + 512); R.iv[q] = *(const u32x4*)(rowp + 1024); }
    return R;
}
__device__ __forceinline__ void hgA_item(const Bufs& B, int l, int it, unsigned char* shm, const float* hlb, const HgRegs& R) {
    const int tid = tid_v(), lane = tid & 63, wid = tid >> 6;
    const int bh = it >> 5, ch = it & 31, b = bh >> 2, h = bh & 3, m0 = b * 2048 + ch * 64;
    float* cumS = (float*)shm;
    bf16_t* kdT = (bf16_t*)(shm + 32768);
    bf16_t* iT = (bf16_t*)(shm + 32768 + 18432);
    float* lbS = (float*)(shm + 32768 + 36864);
    hg_cum(R.ev, l, h, hlb, cumS, lbS, tid);
#pragma unroll
    for (int q = 0; q < 2; ++q) {
        const int idx = tid + 512 * q, t = idx >> 4, k8 = (idx & 15) * 8;
        f32x4 a, bb; unpack8(R.ev[q], a, bb);
        const u32x4 iw = R.iv[q];
        const int tx = t ^ (((k8 >> 3) & 7) << 3);
#pragma unroll
        for (int j = 0; j < 4; ++j) {
            kdT[(k8 + j) * 72 + tx] = f2bf(lbS[k8 + j] * a[j] * __expf(cumS[63 * 128 + k8 + j] - cumS[t * 128 + k8 + j]));
            kdT[(k8 + 4 + j) * 72 + tx] = f2bf(lbS[k8 + 4 + j] * bb[j] * __expf(cumS[63 * 128 + k8 + 4 + j] - cumS[t * 128 + k8 + 4 + j]));
        }
        iT[(k8 + 0) * 72 + tx] = (bf16_t)(iw.x & 0xffffu); iT[(k8 + 1) * 72 + tx] = (bf16_t)(iw.x >> 16); iT[(k8 + 2) * 72 + tx] = (bf16_t)(iw.y & 0xffffu); iT[(k8 + 3) * 72 + tx] = (bf16_t)(iw.y >> 16);
        iT[(k8 + 4) * 72 + tx] = (bf16_t)(iw.z & 0xffffu); iT[(k8 + 5) * 72 + tx] = (bf16_t)(iw.z >> 16); iT[(k8 + 6) * 72 + tx] = (bf16_t)(iw.w & 0xffffu); iT[(k8 + 7) * 72 + tx] = (bf16_t)(iw.w >> 16);
    }
    if (tid < 128) B.DEC[it * 128 + tid] = __expf(cumS[63 * 128 + tid]);
    __syncthreads();
    bf16_t* Sg = B.St + (size_t)it * 16384;
    for (int tile = wid; tile < 64; tile += 8) {
        const int tm = tile >> 3, tn = tile & 7;
        const f32x4 acc = mma_tile64<true, true>(iT, tm * 16, kdT, tn * 16, lane);
#pragma unroll
        for (int j = 0; j < 4; ++j) Sg[(tm * 16 + (lane >> 4) * 4 + j) * 128 + tn * 16 + (lane & 15)] = f2bf(acc[j]);
    }
}

__device__ __forceinline__ void hgC_item(const Bufs& B, int l, int it, unsigned char* shm, const float* hlb, const float* hn) {
    const int tid = tid_v(), lane = tid & 63, wid = tid >> 6;
    const int bh = it >> 5, ch = it & 31, b = bh >> 2, h = bh & 3, m0 = b * 2048 + ch * 64;
    float* cumS = (float*)shm;
    bf16_t* qe = (bf16_t*)(shm + 33792);
    bf16_t* qa = (bf16_t*)(shm + 51200);
    bf16_t* kb = (bf16_t*)(shm + 68608);
    bf16_t* iT = (bf16_t*)(shm + 86016);
    bf16_t* P = (bf16_t*)(shm + 104448);
    float* lbS = (float*)(shm + 113664);
    bf16x8 sf[4]; load_bfrag<4>(sf, B.St + (size_t)it * 16384 + wid * 16 * 128, 128, lane);
    u32x4 ev[2], iv[2], qv[2];
#pragma unroll
    for (int q = 0; q < 2; ++q) { const int idx = tid + 512 * q; const bf16_t* rowp = B.bufD + (size_t)(m0 + (idx >> 4)) * 1536 + h * 128 + (idx & 15) * 8; qv[q] = *(const u32x4*)rowp; ev[q] = *(const u32x4*)(rowp + 512); iv[q] = *(const u32x4*)(rowp + 1024); }
    hg_cum(ev, l, h, hlb, cumS, lbS, tid);
#pragma unroll
    for (int q = 0; q < 2; ++q) {
        const int idx = tid + 512 * q, t = idx >> 4, k8 = (idx & 15) * 8;
        f32x4 q0, q1, e0, e1; unpack8(qv[q], q0, q1); unpack8(ev[q], e0, e1);
        const u32x4 iw = iv[q];
        const int tx = t ^ (((k8 >> 3) & 7) << 3);
        const f32x4 c0 = *(const f32x4*)(cumS + t * 128 + k8), c1 = *(const f32x4*)(cumS + t * 128 + k8 + 4), m0v = *(const f32x4*)(cumS + 31 * 128 + k8), m1v = *(const f32x4*)(cumS + 31 * 128 + k8 + 4);
        const f32x4 l0 = *(const f32x4*)(lbS + k8), l1 = *(const f32x4*)(lbS + k8 + 4);
        f32x4 x0, x1, y0, y1, z0, z1;
#pragma unroll
        for (int j = 0; j < 4; ++j) {
            x0[j] = q0[j] * __expf(c0[j]); x1[j] = q1[j] * __expf(c1[j]);
            y0[j] = q0[j] * __expf(fminf(c0[j] - m0v[j], 80.f)); y1[j] = q1[j] * __expf(fminf(c1[j] - m1v[j], 80.f));
            z0[j] = l0[j] * e0[j] * __expf(fminf(m0v[j] - c0[j], 80.f)); z1[j] = l1[j] * e1[j] * __expf(fminf(m1v[j] - c1[j], 80.f));
        }
        *(u32x4*)(qe + t * 136 + k8) = pack8(x0, x1); *(u32x4*)(qa + t * 136 + k8) = pack8(y0, y1); *(u32x4*)(kb + t * 136 + k8) = pack8(z0, z1);
        iT[(k8 + 0) * 72 + tx] = (bf16_t)(iw.x & 0xffffu); iT[(k8 + 1) * 72 + tx] = (bf16_t)(iw.x >> 16); iT[(k8 + 2) * 72 + tx] = (bf16_t)(iw.y & 0xffffu); iT[(k8 + 3) * 72 + tx] = (bf16_t)(iw.y >> 16);
        iT[(k8 + 4) * 72 + tx] = (bf16_t)(iw.z & 0xffffu); iT[(k8 + 5) * 72 + tx] = (bf16_t)(iw.z >> 16); iT[(k8 + 6) * 72 + tx] = (bf16_t)(iw.w & 0xffffu); iT[(k8 + 7) * 72 + tx] = (bf16_t)(iw.w >> 16);
    }
    __syncthreads();
    for (int tile = wid; tile < 16; tile += 8) {
        const int tm = tile >> 2, tn = tile & 3;
        f32x4 acc = {0.f, 0.f, 0.f, 0.f};
        if (tn <= tm) acc = mma_tile(qa + tm * 16 * 136, 136, kb + tn * 16 * 136, 136, 128, lane);
        const int sc = tn * 16 + (lane & 15);
#pragma unroll
        for (int j = 0; j < 4; ++j) { const int t = tm * 16 + (lane >> 4) * 4 + j; P[t * 72 + sc] = f2bf(sc <= t ? acc[j] : 0.f); }
    }
    __syncthreads();
    float* oS = cumS;
    for (int tile = wid; tile < 32; tile += 8) {
        const int tm = tile >> 3, tn = tile & 7;
        const f32x4 acc = mma_tile_pre<4>(qe + tm * 16 * 136, 136, sf, lane) + mma_tile64<false, true>(P, tm * 16, iT, tn * 16, lane);
#pragma unroll
        for (int j = 0; j < 4; ++j) oS[(tm * 16 + (lane >> 4) * 4 + j) * 132 + tn * 16 + (lane & 15)] = acc[j];
    }
    __syncthreads();
#pragma unroll
    for (int q = 0; q < 2; ++q) {
        const int idx = tid + 512 * q, t = idx >> 4, v8 = (idx & 15) * 8;
        f32x4 o0 = *(const f32x4*)(oS + t * 132 + v8), o1 = *(const f32x4*)(oS + t * 132 + v8 + 4);
        float ssq = o0[0] * o0[0] + o0[1] * o0[1] + o0[2] * o0[2] + o0[3] * o0[3] + o1[0] * o1[0] + o1[1] * o1[1] + o1[2] * o1[2] + o1[3] * o1[3];
        ssq = rsum16(ssq);
        const float rs = rsqrtf(ssq * (1.0f / 128.0f) + 1e-6f);
        const f32x4 n0 = *(const f32x4*)(hn + h * 128 + v8), n1 = *(const f32x4*)(hn + h * 128 + v8 + 4);
        *(u32x4*)(B.br + 3 * VEC_STRIDE + (size_t)(m0 + t) * 512 + h * 128 + v8) = pack8(o0 * rs * n0, o1 * rs * n1);
    }
}

__device__ __forceinline__ void phase2(int l, int s, unsigned char* shm) {
    const Bufs B = make_bufs(WSP(), l);
    const float* hlb = IN(21);
    {
        const int lane = tid_v() & 63, wid = tid_v() >> 6;
        bf16x8 w2f[4][2], a2f[4][2];
#pragma unroll
        for (int i = 0; i < 4; ++i) { const int tn = wid + 8 * i; load_bfrag<2>(w2f[i], B.W + oW2 + tn * 16 * 64, 64, lane); load_bfrag<2>(a2f[i], B.W + oA2 + tn * 16 * 64, 64, lane); }
        const int tid = tid_v(), G = (int)gridDim.x; int it = bid_s();
        PrepRegs R = prep_issue(B, s, it, tid);
        for (; it < 1024; it += G) { const PrepRegs N = prep_issue(B, s, it + G < 1024 ? it + G : it, tid); prep_item(B, l, s, it, shm, w2f, a2f, R); R = N; }
    }
    {
        const int tid = tid_v(), G = (int)gridDim.x; int it = bid_s();
        HgRegs R = hgA_issue(B, it, tid);
        for (; it < 1024; it += G) { const HgRegs N = hgA_issue(B, it + G < 1024 ? it + G : it, tid); hgA_item(B, l, it, shm, hlb, R); R = N; }
    }
    for (int it = bid_s(); it < 512; it += gridDim.x) sg_item(B, l, s, it, shm);
    {
        const int tid = tid_v(), G = (int)gridDim.x; int it = bid_s();
        PoolRegs R = pool_issue(B, s, it, tid);
        for (; it < 1024; it += G) { const PoolRegs N = pool_issue(B, s, it + G < 1024 ? it + G : it, tid); pool_item(B, l, s, it, shm, R); R = N; }
    }
}
__device__ __forceinline__ void scans(int l, int s, unsigned char* shm) {
    const Bufs B = make_bufs(WSP(), l);
    constexpr int CS = 16, NCH = 2048 / CS, RST = 340;
    const int tid = tid_v(), lane = tid & 63, wid = tid >> 6;
    const int c = bid_s(), xcd = c & 7, jj = c >> 3;
    const int bhr = xcd * 8 + (jj >> 2), b_r = bhr >> 3, h_r = bhr & 7, rbase = (jj & 3) * 16;
    float* rbuf = (float*)shm;
    float* yl = (float*)(shm + 2 * CS * RST * 4);
    bf16_t* Y = B.br + VEC_STRIDE;
    __syncthreads();
    if (wid < 4) {
        const int loc = wid * 4 + (lane >> 4), col4 = (lane & 15) * 4;
        float* RSp = B.RS + ((size_t)bhr * 64 + rbase + loc) * 64 + col4;
        f32x2 S0 = {0.f, 0.f}, S1 = {0.f, 0.f};
        if (s == 1) { const f32x4 t = *(const f32x4*)RSp; S0 = t.xy; S1 = t.zw; }
        asm volatile("" : "+v"(S0), "+v"(S1));
        __syncthreads();
#pragma unroll 1
        for (int cidx = 0; cidx < NCH; ++cidx) {
            if (cidx > 0) { const int st = tid >> 4, r = tid & 15; Y[(size_t)(b_r * 2048 + (cidx - 1) * CS + st) * 512 + h_r * 64 + rbase + r] = f2bf(yl[((cidx - 1) & 1) * (CS * 16) + tid]); }
            const float* bp = rbuf + (cidx & 1) * (CS * RST); float* ylw = yl + (cidx & 1) * (CS * 16);
            const unsigned ab = (unsigned)(size_t)(PG8_LAS const float*)bp;
            const unsigned a_col = ab + col4 * 4, a_row = ab + 1280 + loc * 4, a_cc = ab + 1344;
            f32x4 Aw4, Akk4, Awr4, Aka4, Akp4, Bw4, Bkk4, Bwr4, Bka4, Bkp4; float Av, Bv; f32x2 Acc, Bcc;
            float ykeep = 0.f;
#define RW_LOAD(P, ST) do { \
                asm volatile("ds_read_b128 %0, %1 offset:%2" : "=v"(P##w4) : "v"(a_col), "n"((ST) * 1360)); \
                asm volatile("ds_read_b128 %0, %1 offset:%2" : "=v"(P##kk4) : "v"(a_col), "n"((ST) * 1360 + 256)); \
                asm volatile("ds_read_b128 %0, %1 offset:%2" : "=v"(P##wr4) : "v"(a_col), "n"((ST) * 1360 + 512)); \
                asm volatile("ds_read_b128 %0, %1 offset:%2" : "=v"(P##ka4) : "v"(a_col), "n"((ST) * 1360 + 768)); \
                asm volatile("ds_read_b128 %0, %1 offset:%2" : "=v"(P##kp4) : "v"(a_col), "n"((ST) * 1360 + 1024)); \
                asm volatile("ds_read_b32 %0, %1 offset:%2" : "=v"(P##v) : "v"(a_row), "n"((ST) * 1360)); \
                asm volatile("ds_read_b64 %0, %1 offset:%2" : "=v"(P##cc) : "v"(a_cc), "n"((ST) * 1360)); } while (0)
#define RW_WAIT(P, N) asm volatile("s_waitcnt lgkmcnt(" #N ")" : "+v"(P##w4), "+v"(P##kk4), "+v"(P##wr4), "+v"(P##ka4), "+v"(P##kp4), "+v"(P##v), "+v"(P##cc))
#define RW_STEP(P, ST) do { \
                f32x2 t = S0 * P##kk4.xy; t = S1 * P##kk4.zw + t; \
                f32x2 u = S0 * P##wr4.xy; u = S1 * P##wr4.zw + u; \
                const f32x2 vv = {P##v, P##v}; \
                const f32x2 Ta = S0 * P##w4.xy + vv * P##kp4.xy, Tb = S1 * P##w4.zw + vv * P##kp4.zw; \
                float pd = t.x + t.y, yq = u.x + u.y; \
                pd = rsum16(pd); yq = rsum16(yq); \
                const float sa = -pd; const f32x2 sa2 = {sa, sa}; \
                S0 = Ta + sa2 * P##ka4.xy; S1 = Tb + sa2 * P##ka4.zw; \
                const float y = yq + sa * P##cc.x + P##v * P##cc.y; \
                ykeep = (lane & 15) == (ST) ? y : ykeep; } while (0)
#define RW_PAIR(ST) do { RW_LOAD(B, (ST) + 1); RW_WAIT(A, 7); RW_STEP(A, ST); RW_LOAD(A, (ST) + 2); RW_WAIT(B, 7); RW_STEP(B, (ST) + 1); } while (0)
            RW_LOAD(A, 0);
            RW_PAIR(0); RW_PAIR(2); RW_PAIR(4); RW_PAIR(6); RW_PAIR(8); RW_PAIR(10); RW_PAIR(12);
            RW_LOAD(B, 15); RW_WAIT(A, 7); RW_STEP(A, 14); RW_WAIT(B, 0); RW_STEP(B, 15);
#undef RW_PAIR
#undef RW_STEP
#undef RW_WAIT
#undef RW_LOAD
            ylw[(lane & 15) * 16 + loc] = ykeep;
            __syncthreads();
        }
        { const int st = tid >> 4, r = tid & 15; Y[(size_t)(b_r * 2048 + (NCH - 1) * CS + st) * 512 + h_r * 64 + rbase + r] = f2bf(yl[((NCH - 1) & 1) * (CS * 16) + tid]); }
        { f32x4 t; t.xy = S0; t.zw = S1; *(f32x4*)RSp = t; }
    } else {
        const int lt = tid - 256;
        const unsigned char* src[4]; unsigned inc[4]; int dsto[4]; bool isf[4], act[4];
#pragma unroll
        for (int i = 0; i < 4; ++i) {
            int idx = lt + 256 * i; act[i] = idx < CS * 50; idx = act[i] ? idx : CS * 50 - 1;
            const int st = idx / 50, k = idx - st * 50;
            const size_t m = (size_t)(b_r * 2048 + st) * 512 + h_r * 64;
            if (k < 16) { src[i] = (const unsigned char*)(B.Wf + m + k * 4); inc[i] = CS * 512 * 4; dsto[i] = st * RST + k * 4; isf[i] = true; }
            else if (k < 48) { src[i] = (const unsigned char*)(B.KK + (size_t)((k - 16) >> 3) * VEC_STRIDE + m + ((k - 16) & 7) * 8); inc[i] = CS * 512 * 2; dsto[i] = st * RST + 64 * (1 + ((k - 16) >> 3)) + ((k - 16) & 7) * 8; isf[i] = false; }
            else { src[i] = (const unsigned char*)(B.V + m + rbase + (k - 48) * 8); inc[i] = CS * 512 * 2; dsto[i] = st * RST + 320 + (k - 48) * 8; isf[i] = false; }
        }
        const float* c1p = B.C1 + (size_t)(b_r * 2048 + (lt & (CS - 1))) * 8 + h_r; const float* c2p = B.C2 + (size_t)(b_r * 2048 + (lt & (CS - 1))) * 8 + h_r;
        const int e = c * 256 + lt, bhh = e >> 11, hv = (e >> 4) & 127, hk8 = (e & 15) * 8;
        float* HSp = B.HS + ((size_t)bhh * 128 + hv) * 128 + hk8;
        f32x4 h0 = {0.f, 0.f, 0.f, 0.f}, h1 = {0.f, 0.f, 0.f, 0.f};
        if (s == 1) { h0 = *(const f32x4*)HSp; h1 = *(const f32x4*)(HSp + 4); }
        asm volatile("" : "+v"(h0), "+v"(h1));
        u32x4 rrA[4], rrB[4]; float s1A, s2A, s1B, s2B;
        u32x4 Lw = *(const u32x4*)(B.St + ((size_t)(bhh * 32) * 128 + hv) * 128 + hk8);
        f32x4 d0 = *(const f32x4*)(B.DEC + (bhh * 32) * 128 + hk8), d1 = *(const f32x4*)(B.DEC + (bhh * 32) * 128 + hk8 + 4);
#define LD_ISSUE(rr, sc1, sc2) do { _Pragma("unroll") for (int i = 0; i < 4; ++i) { rr[i] = *(const u32x4*)src[i]; src[i] += inc[i]; } sc1 = *c1p; sc2 = *c2p; c1p += CS * 8; c2p += CS * 8; } while (0)
#define LD_STORE(rr, sc1, sc2, par) do { float* rb = rbuf + (par) * (CS * RST); \
            _Pragma("unroll") for (int i = 0; i < 4; ++i) { if (act[i]) { float* dst = rb + dsto[i]; \
                if (isf[i]) { *(u32x4*)dst = rr[i]; } else { f32x4 a, bb; unpack8(rr[i], a, bb); *(f32x4*)dst = a; *(f32x4*)(dst + 4) = bb; } } } \
            if (lt < CS) { rb[lt * RST + 336] = sc1; rb[lt * RST + 337] = sc2; } } while (0)
        LD_ISSUE(rrA, s1A, s2A); LD_STORE(rrA, s1A, s2A, 0); LD_ISSUE(rrA, s1A, s2A);
        __syncthreads();
#pragma unroll 1
        for (int cidx = 0; cidx < NCH; cidx += 4) {
            LD_ISSUE(rrB, s1B, s2B);
            {
                bf16_t* sp = B.St + ((size_t)(bhh * 32 + (cidx >> 2)) * 128 + hv) * 128 + hk8;
                *(u32x4*)sp = pack8(h0, h1);
                f32x4 l0, l1; unpack8(Lw, l0, l1);
                h0 = d0 * h0 + l0; h1 = d1 * h1 + l1;
            }
            LD_STORE(rrA, s1A, s2A, 1);
            __syncthreads();
            LD_ISSUE(rrA, s1A, s2A);
            LD_STORE(rrB, s1B, s2B, 0);
            __syncthreads();
            LD_ISSUE(rrB, s1B, s2B);
            {   const int pn = (cidx >> 2) + 1, item = bhh * 32 + (pn < 32 ? pn : 31);
                Lw = *(const u32x4*)(B.St + ((size_t)item * 128 + hv) * 128 + hk8);
                d0 = *(const f32x4*)(B.DEC + item * 128 + hk8); d1 = *(const f32x4*)(B.DEC + item * 128 + hk8 + 4); }
            LD_STORE(rrA, s1A, s2A, 1);
            __syncthreads();
            LD_ISSUE(rrA, s1A, s2A);
            LD_STORE(rrB, s1B, s2B, 0);
            __syncthreads();
        }
        *(f32x4*)HSp = h0; *(f32x4*)(HSp + 4) = h1;
#undef LD_ISSUE
#undef LD_STORE
    }
}

__device__ __forceinline__ void phase4(int l, unsigned char* shm) {
    const Bufs B = make_bufs(WSP(), l);
    const int lane = tid_v() & 63, gw = bid_s() * 8 + (tid_v() >> 6);
    const float* lnw = IN(15) + l * 512; const float* lnb = IN(16) + l * 512; const float* hn = IN(22) + l * 512;
    bf16_t* Y = B.br + VEC_STRIDE;
    for (int mb = gw; mb < MS; mb += 4096) {
        const int c0 = lane * 8, h = lane >> 3;
        u32x4 yw[2], gwd[2], vwd[2]; float c3v[2];
#pragma unroll
        for (int u = 0; u < 2; ++u) { const size_t o = (size_t)(mb + 2048 * u) * 512 + c0; yw[u] = *(const u32x4*)(Y + o); gwd[u] = *(const u32x4*)(B.G + o); vwd[u] = *(const u32x4*)(B.V + o); c3v[u] = B.C3[(mb + 2048 * u) * 8 + h]; }
        const f32x4 w0 = *(const f32x4*)(lnw + c0), w1 = *(const f32x4*)(lnw + c0 + 4), b0 = *(const f32x4*)(lnb + c0), b1 = *(const f32x4*)(lnb + c0 + 4);
#pragma unroll
        for (int u = 0; u < 2; ++u) {
            const size_t o = (size_t)(mb + 2048 * u) * 512 + c0;
            f32x4 y0, y1, g0, g1, v0, v1;
            unpack8(yw[u], y0, y1); unpack8(gwd[u], g0, g1); unpack8(vwd[u], v0, v1);
            const float c3 = c3v[u];
            const float mean = rsum8((y0[0] + y0[1]) + (y0[2] + y0[3]) + (y1[0] + y1[1]) + (y1[2] + y1[3])) * (1.0f / 64.0f);
            const f32x4 d0 = y0 - mean, d1 = y1 - mean;
            const float var = rsum8(d0[0] * d0[0] + d0[1] * d0[1] + d0[2] * d0[2] + d0[3] * d0[3] + d1[0] * d1[0] + d1[1] * d1[1] + d1[2] * d1[2] + d1[3] * d1[3]) * (1.0f / 64.0f);
            const float rstd = rsqrtf(var + 64e-5f);
            const f32x4 r0 = (d0 * rstd * w0 + b0 + c3 * v0) * g0, r1 = (d1 * rstd * w1 + b1 + c3 * v1) * g1;
            *(u32x4*)(Y + o) = pack8(r0, r1);
        }
    }
    const float* hlb = IN(21);
    for (int it = bid_s(); it < 1024; it += gridDim.x) hgC_item(B, l, it, shm, hlb, hn);
}

__device__ __forceinline__ void phase8(int l, int s) {
    const Bufs B = make_bufs(WSP(), l);
    const float* cw = IN(27) + (size_t)l * 3 * 5632; const float* cb = IN(28) + (size_t)l * 5632;
    const int tid = tid_v();
    if (tid >= 352) return;
    const int j0 = tid * 8;
    f32x4 wg[3][2], wv[3][2], bg[2], bv[2];
#pragma unroll
    for (int e = 0; e < 2; ++e) {
        bg[e] = *(const f32x4*)(cb + j0 + 4 * e); bv[e] = *(const f32x4*)(cb + 2816 + j0 + 4 * e);
#pragma unroll
        for (int tap = 0; tap < 3; ++tap) { wg[tap][e] = *(const f32x4*)(cw + (size_t)tap * 5632 + j0 + 4 * e); wv[tap][e] = *(const f32x4*)(cw + (size_t)tap * 5632 + 2816 + j0 + 4 * e); }
    }
    const u32x4 zero4 = {0u, 0u, 0u, 0u};
    for (int blk = bid_s(); blk < MS / 64; blk += gridDim.x) {
        const int mbeg = blk * 64, b = mbeg >> 11, tl0 = mbeg & 2047;
        const bf16_t* ub = B.bufU + (size_t)mbeg * 5632 + j0;
        u32x4 hg1, hv1, hg2, hv2;
        if (tl0 > 0) { hg1 = *(const u32x4*)(ub - 5632); hv1 = *(const u32x4*)(ub - 5632 + 2816); hg2 = *(const u32x4*)(ub - 2 * 5632); hv2 = *(const u32x4*)(ub - 2 * 5632 + 2816); }
        else if (s == 1) { const bf16_t* sp = B.saveU + (size_t)(b * 2) * 5632 + j0; hg1 = *(const u32x4*)(sp + 5632); hv1 = *(const u32x4*)(sp + 5632 + 2816); hg2 = *(const u32x4*)sp; hv2 = *(const u32x4*)(sp + 2816); }
        else { hg1 = zero4; hv1 = zero4; hg2 = zero4; hv2 = zero4; }
        f32x4 g1[2], v1[2], g2[2], v2[2];
        unpack8(hg1, g1[0], g1[1]); unpack8(hv1, v1[0], v1[1]); unpack8(hg2, g2[0], g2[1]); unpack8(hv2, v2[0], v2[1]);
#pragma unroll 1
        for (int r0 = 0; r0 < 64; r0 += 4) {
            u32x4 gw[4], vw[4];
#pragma unroll
            for (int q = 0; q < 4; ++q) { gw[q] = *(const u32x4*)(ub + (size_t)(r0 + q) * 5632); vw[q] = *(const u32x4*)(ub + (size_t)(r0 + q) * 5632 + 2816); }
#pragma unroll
            for (int q = 0; q < 4; ++q) {
                const int m = mbeg + r0 + q, tl = tl0 + r0 + q;
                if (s == 0 && tl >= 2046) { bf16_t* sp = B.saveU + (size_t)(b * 2 + tl - 2046) * 5632 + j0; *(u32x4*)sp = gw[q]; *(u32x4*)(sp + 2816) = vw[q]; }
                f32x4 gc[2], vc[2]; unpack8(gw[q], gc[0], gc[1]); unpack8(vw[q], vc[0], vc[1]);
                f32x4 og[2], ov[2];
#pragma unroll
                for (int e = 0; e < 2; ++e) {
                    og[e] = bg[e] + wg[2][e] * gc[e] + wg[1][e] * g1[e] + wg[0][e] * g2[e];
                    ov[e] = bv[e] + wv[2][e] * vc[e] + wv[1][e] * v1[e] + wv[0][e] * v2[e];
#pragma unroll
                    for (int j = 0; j < 4; ++j) og[e][j] = gelu_t(og[e][j]) * ov[e][j];
                    g2[e] = g1[e]; v2[e] = v1[e]; g1[e] = gc[e]; v1[e] = vc[e];
                }
                *(u32x4*)(B.act + (size_t)m * 2816 + j0) = pack8(og[0], og[1]);
            }
        }
    }
}

__device__ __forceinline__ void phase_final() {
    float* outp = OUTP();
    const int lane = tid_v() & 63, gw = bid_s() * 8 + (tid_v() >> 6);
    const f32x4* gm = (const f32x4*)IN(33);
    for (int mb = gw; mb < 32768; mb += 4096) {
        f32x4 v[2][4];
#pragma unroll
        for (int u = 0; u < 2; ++u) { const f32x4* xr = (const f32x4*)(outp + (size_t)(mb + 2048 * u) * 1024);
#pragma unroll
            for (int i = 0; i < 4; ++i) v[u][i] = xr[lane + 64 * i]; }
#pragma unroll
        for (int u = 0; u < 2; ++u) { f32x4* xr = (f32x4*)(outp + (size_t)(mb + 2048 * u) * 1024); float sum = 0.f;
#pragma unroll
            for (int i = 0; i < 4; ++i) sum += v[u][i][0] * v[u][i][0] + v[u][i][1] * v[u][i][1] + v[u][i][2] * v[u][i][2] + v[u][i][3] * v[u][i][3];
            sum = wsum(sum);
            const float rs = rsqrtf(sum * (1.0f / 1024.0f) + 1e-6f);
#pragma unroll
            for (int i = 0; i < 4; ++i) xr[lane + 64 * i] = v[u][i] * rs * gm[lane + 64 * i]; }
    }
}

__global__ void __launch_bounds__(512, 2) mega(Params p) {
    extern __shared__ __attribute__((aligned(16))) unsigned char shm[];
    cg::grid_group grid = cg::this_grid();
    PG8_LAS unsigned char* lds = (PG8_LAS unsigned char*)shm;
    constexpr int G = 256; const int c = (int)bid_s();
    volatile PG8_LAS unsigned* bst = (volatile PG8_LAS unsigned*)(lds + 131072);
    if (tid_v() < 4) bst[tid_v()] = 0u;
    __syncthreads();
    if (bid_s() == 0) { unsigned* bw = (unsigned*)(WSP() + BAR_OFF); for (int i = tid_v(); i < XCD_BAR_WORDS; i += 512) bw[i] = 0u; }
    phase0(shm);
    phaseX(0, 0);
    grid.sync();
    const XcdBarrier xb = xcd_barrier_post((unsigned*)(WSP() + BAR_OFF), bst);
#pragma unroll 1
    for (int ls = 0; ls < 4; ++ls) {
        const int l = ls >> 1, s = ls & 1;
        if (ls != 0) { phaseX(l, s); xcd_barrier(xb); }
        {
            const Bufs B = make_bufs(WSP(), l);
            StaticOrder S; S.init(MS, 4864, G, c);
            EpiProj E{B.ss0, B.bufA, B.bufB, B.bufC, B.bufD};
            gemm_phase(lds, Gemm{B.xb, B.W + oWin, MS, 4864, 1024}, S, E);
        }
        xcd_barrier(xb);
        phase2(l, s, shm);
        xcd_barrier(xb);
        scans(l, s, shm);
        xcd_barrier(xb);
        phase4(l, shm);
        xcd_barrier(xb);
        {
            const Bufs B = make_bufs(WSP(), l);
            StaticOrder S0; S0.init(MS, 1024, G, c);
            P5Order S; S0.next(0, S.t); S.xb = B.xb; S.Wg = B.W + oWin + (size_t)4864 * 1024; S.br = B.br; S.Wb = B.W + oWb; S.brs = VEC_STRIDE;
            EpiP5 E{B.ss0, B.gates, B.mrg, B.mb};
            gemm_phase_x(lds, S, E);
        }
        xcd_barrier(xb);
        {
            const Bufs B = make_bufs(WSP(), l);
            StaticOrder S; S.init(MS, 1024, G, c);
            EpiRes E{l == 0 ? IN(0) : OUTP(), OUTP(), B.xb, B.ss1, s};
            gemm_phase(lds, Gemm{B.mb, B.W + oWo, MS, 1024, launder_s(1024)}, S, E);
        }
        xcd_barrier(xb);
        {
            const Bufs B = make_bufs(WSP(), l);
            StaticOrder S; S.init(MS, 5632, G, c);
            EpiBf<0> E{B.ss1, B.bufU, 5632};
            gemm_phase(lds, Gemm{B.xb, B.W + oWup, MS, 5632, launder_s(1024)}, S, E);
        }
        xcd_barrier(xb);
        phase8(l, s);
        xcd_barrier(xb);
        {
            const Bufs B = make_bufs(WSP(), l);
            StaticOrder S; S.init(MS, 1024, G, c);
            EpiRes E{OUTP(), OUTP(), B.xb, B.ss2, s};
            gemm_phase(lds, Gemm{B.act, B.W + oWd, MS, 1024, launder_s(2816)}, S, E);
        }
        xcd_barrier(xb);
        {
            const Bufs B = make_bufs(WSP(), l);
            StaticOrder S0; S0.init(MS, 1024, G, c);
            P10Order S; S0.next(0, S.t); S.pb = B.pb; S.Wp = B.W + oWp; S.xb = B.xb; S.Wg = B.W + oWg;
            EpiP10 E{B.ss2, B.pp, OUTP(), s};
            gemm_phase_x(lds, S, E);
        }
        xcd_barrier(xb);
    }
    phase_final();
}

extern "C" void kernel_launch(void* const* d_in, const int* in_sizes, int n_in, void* d_out, int out_size,
                              void* d_ws, size_t ws_size, hipStream_t stream) {
    constexpr size_t kDynLds = 131072 + 64;
    static int grid_blocks = 0;
    if (!grid_blocks) {
        (void)hipFuncSetAttribute((const void*)mega, hipFuncAttributeMaxDynamicSharedMemorySize, (int)kDynLds);
        int dev = 0, cus = 0, per_cu = 0;
        (void)hipGetDevice(&dev);
        (void)hipDeviceGetAttribute(&cus, hipDeviceAttributeMultiprocessorCount, dev);
        (void)hipOccupancyMaxActiveBlocksPerMultiprocessor(&per_cu, mega, 512, kDynLds);
        grid_blocks = cus * per_cu;
        if (grid_blocks > 256) grid_blocks = 256;
        if (grid_blocks != 256) { fprintf(stderr, "this kernel needs 256 co-resident workgroups, got %d\n", grid_blocks); grid_blocks = 0; }
    }
    Params p{};
    for (int i = 0; i < 34; ++i) p.in[i] = (const float*)d_in[i];
    p.out = (float*)d_out; p.ws = (unsigned char*)d_ws;
    void* args[] = {&p};
    if (grid_blocks != 256) return;
    hipError_t e = hipLaunchCooperativeKernel((void*)mega, dim3(grid_blocks), dim3(512), args, kDynLds, stream);
    if (e != hipSuccess) fprintf(stderr, "cooperative launch failed: %s (grid %d)\n", hipGetErrorString(e), grid_blocks);
}
```
